# Optimizing an MI355X kernel written in HIP

```python
import math
import jax, jax.numpy as jnp
from jax import lax
import numpy as np

D_MODEL = 1024
BATCH = 2
SEQ = 8192
DEPTH = 2

GRID_W = 64
CTX_LEN = 256
EPS = 1e-6

N_BRANCH = 4
BRANCH_W = 512

POOL_GROUPS = 4
POOL_GC = BRANCH_W // POOL_GROUPS
POOL_WINDOWS = (2, 4, 8, 16)

DIFF_HEADS = 4
DIFF_DH = 64
DIFF_DV = BRANCH_W // DIFF_HEADS
DIFF_QBLOCK = 128
ROPE_BASE = 10000.0

SGU_GROUPS = 4
SGU_GC = BRANCH_W // SGU_GROUPS
SGU_CHUNK = 128

NA_HEADS = 8
NA_DH = BRANCH_W // NA_HEADS
NA_WIN_R = 8
NA_WIN_C = 16

N_EXPERTS = 16
EC_CAPACITY = 2
D_EXPERT = 1024

COL_SIZES = (
    DIFF_HEADS * 2 * DIFF_DH,
    BRANCH_W,
    BRANCH_W,
    BRANCH_W,
    DIFF_HEADS * 2 * DIFF_DH,
    BRANCH_W,
    BRANCH_W,
    BRANCH_W,
    BRANCH_W,
    N_BRANCH * D_MODEL,
)
KV_COLS = sum(COL_SIZES[:4])
IN_COLS = sum(COL_SIZES)

kernel_name = "hybrid_gated_branch_dit_block"


def rmsnorm(x, g):
    xf = x.astype(jnp.float32)
    y = xf * lax.rsqrt(jnp.mean(xf * xf, axis=-1, keepdims=True) + EPS)
    return y.astype(x.dtype) * g


def layernorm(x, g):
    xf = x.astype(jnp.float32)
    xc = xf - jnp.mean(xf, axis=-1, keepdims=True)
    y = xc * lax.rsqrt(jnp.mean(xc * xc, axis=-1, keepdims=True) + EPS)
    return y.astype(x.dtype) * g


def modulate(h, shift, scale):
    return h * (1 + scale) + shift


def split_cols(z, sizes):
    offs = np.cumsum(sizes)[:-1]
    return jnp.split(z, [int(o) for o in offs], axis=-1)


def rope_tables(T):
    t = jnp.arange(T)
    row = (t // GRID_W).astype(jnp.float32)
    col = (t % GRID_W).astype(jnp.float32)
    nf = DIFF_DH // 4
    inv = ROPE_BASE ** (-jnp.arange(nf, dtype=jnp.float32) / nf)
    ar = row[:, None] * inv
    ac = col[:, None] * inv
    return (jnp.cos(ar), jnp.sin(ar), jnp.cos(ac), jnp.sin(ac))


def rotate(x, cos, sin):
    x1, x2 = jnp.split(x, 2, axis=-1)
    return jnp.concatenate([x1 * cos - x2 * sin, x1 * sin + x2 * cos], axis=-1).astype(x.dtype)


def rope2d(x, tabs):
    cr, sr, cc, sc = [a[None, :, None, None, :] for a in tabs]
    xr, xcol = jnp.split(x, 2, axis=-1)
    return jnp.concatenate([rotate(xr, cr, sr), rotate(xcol, cc, sc)], axis=-1)


def pool_mixer(z, w_pool, scale):
    B, T, _ = z.shape
    zf = z.reshape(B, T, POOL_GROUPS, POOL_GC).astype(jnp.float32)
    cs = jnp.concatenate([jnp.zeros((B, 1, POOL_GROUPS, POOL_GC), jnp.float32),
                          jnp.cumsum(zf, axis=1)], axis=1)
    t = jnp.arange(T)
    means = []
    for g, w in enumerate(POOL_WINDOWS):
        lo = jnp.clip(t - w // 2, 0, T)
        hi = jnp.clip(t + w // 2, 0, T)
        cnt = (hi - lo).astype(jnp.float32)[None, :, None]
        means.append((cs[:, hi, g] - cs[:, lo, g]) / cnt)
    pooled = jnp.stack(means, axis=2)
    d = (pooled - zf).astype(z.dtype)
    y = jnp.einsum('btgc,gce->btge', d, w_pool)
    return y.reshape(B, T, BRANCH_W) * scale


def compute_lambda(lam_p, lam_init):
    lp = lam_p.astype(jnp.float32)
    return jnp.exp(jnp.sum(lp[0] * lp[1])) - jnp.exp(jnp.sum(lp[2] * lp[3])) + lam_init


def diff_attend(q, k, v, lam, lam_init, g):
    s = jnp.einsum('bqhmd,bkhmd->bhmqk', q, k).astype(jnp.float32) * (DIFF_DH ** -0.5)
    p = jax.nn.softmax(s, axis=-1)
    a = (p[:, :, 0] - lam * p[:, :, 1]).astype(v.dtype)
    o = jnp.einsum('bhqk,bkhe->bqhe', a, v)
    o = rmsnorm(o, g) * (1.0 - lam_init)
    return o.reshape(o.shape[0], o.shape[1], BRANCH_W)


def diff_latent(q, k, v, lam, lam_init, g):
    B, T = q.shape[0], q.shape[1]
    nb = T // DIFF_QBLOCK
    qb = jnp.moveaxis(q.reshape(B, nb, DIFF_QBLOCK, DIFF_HEADS, 2, DIFF_DH), 1, 0)
    ob = lax.map(lambda qi: diff_attend(qi, k, v, lam, lam_init, g), qb)
    return jnp.moveaxis(ob, 0, 1).reshape(B, T, BRANCH_W)


def dense_attend(q, k, v, heads, dh):
    B, Q, _ = q.shape
    K = k.shape[1]
    qh = q.reshape(B, Q, heads, dh)
    kh = k.reshape(B, K, heads, dh)
    vh = v.reshape(B, K, heads, dh)
    s = jnp.einsum('bqhd,bkhd->bhqk', qh, kh).astype(jnp.float32) * (dh ** -0.5)
    p = jax.nn.softmax(s, axis=-1).astype(v.dtype)
    return jnp.einsum('bhqk,bkhd->bqhd', p, vh).reshape(B, Q, heads * dh)


def na_latent(q, k, v, k_ctx, v_ctx, rpb):
    B, T, _ = q.shape
    rows = T // GRID_W
    kr = min(NA_WIN_R, rows)
    grid = lambda a: a.reshape(B, rows, GRID_W, NA_HEADS, NA_DH)
    qg, kg, vg = grid(q), grid(k), grid(v)
    kc = k_ctx.reshape(B, -1, NA_HEADS, NA_DH)
    vc = v_ctx.reshape(B, -1, NA_HEADS, NA_DH)
    cols = np.arange(GRID_W)
    col_start = np.clip(cols - NA_WIN_C // 2, 0, GRID_W - NA_WIN_C)
    col_idx = col_start[:, None] + np.arange(NA_WIN_C)[None, :]
    dc_idx = col_idx - cols[:, None] + (NA_WIN_C - 1)
    nloc = kr * NA_WIN_C
    scale = NA_DH ** -0.5

    def row_fn(args):
        r, q_row = args
        r0 = jnp.clip(r - kr // 2, 0, rows - kr)
        kwin = lax.dynamic_slice_in_dim(kg, r0, kr, axis=1)[:, :, col_idx]
        vwin = lax.dynamic_slice_in_dim(vg, r0, kr, axis=1)[:, :, col_idx]
        dr_idx = r0 + jnp.arange(kr) - r + (NA_WIN_R - 1)
        bias = rpb[:, dr_idx][:, :, dc_idx].transpose(0, 2, 1, 3)
        s_loc = jnp.einsum('bqhd,biqjhd->bhqij', q_row, kwin).astype(jnp.float32) * scale \
            + bias.astype(jnp.float32)[None]
        s_ctx = jnp.einsum('bqhd,bkhd->bhqk', q_row, kc).astype(jnp.float32) * scale
        s = jnp.concatenate([s_loc.reshape(B, NA_HEADS, GRID_W, nloc), s_ctx], axis=-1)
        p = jax.nn.softmax(s, axis=-1).astype(v.dtype)
        p_loc = p[..., :nloc].reshape(B, NA_HEADS, GRID_W, kr, NA_WIN_C)
        p_ctx = p[..., nloc:]
        return jnp.einsum('bhqij,biqjhd->bqhd', p_loc, vwin) + jnp.einsum('bhqk,bkhd->bqhd', p_ctx, vc)

    out = lax.map(row_fn, (jnp.arange(rows), jnp.moveaxis(qg, 1, 0)))
    return jnp.moveaxis(out, 0, 1).reshape(B, T, BRANCH_W)


def sgu_mixer(u, v, g, w_s, b):
    B, T, _ = u.shape
    n = T // SGU_CHUNK
    u = jax.nn.gelu(u)
    v = layernorm(jax.nn.gelu(v), g)
    vr = v.reshape(B, n, SGU_CHUNK, SGU_GROUPS, SGU_GC)
    f = jnp.einsum('gpq,bnqgc->bnpgc', w_s, vr) + b.T[None, None, :, :, None]
    return u * f.reshape(B, T, BRANCH_W)


def merge(branches, gates, w_br, w_out):
    B, T, _ = gates.shape
    br = jnp.stack(branches, axis=2)
    proj = jnp.einsum('btie,ied->btid', br, w_br)
    gsig = jax.nn.sigmoid(gates.reshape(B, T, N_BRANCH, D_MODEL))
    return jnp.sum(gsig * proj, axis=2) @ w_out


def token_mixer(hx, hc, tabs, p, lam, lam_init, with_ctx_out):
    B, T, _ = hx.shape
    w_in = p['w_in']
    dk, dv, nk, nv, dq, nq, pz, su, sv, gz = split_cols(hx @ w_in, COL_SIZES)
    dk_c, dv_c, nk_c, nv_c = split_cols(hc @ w_in[:, :KV_COLS], COL_SIZES[:4])
    dshape = lambda a: a.reshape(a.shape[0], a.shape[1], DIFF_HEADS, 2, DIFF_DH)
    vshape = lambda a: a.reshape(a.shape[0], a.shape[1], DIFF_HEADS, DIFF_DV)
    k_all = jnp.concatenate([dshape(dk_c), rope2d(dshape(dk), tabs)], axis=1)
    v_all = jnp.concatenate([vshape(dv_c), vshape(dv)], axis=1)
    diff_x = diff_latent(rope2d(dshape(dq), tabs), k_all, v_all, lam, lam_init, p['diff_subln_g'])
    na_x = na_latent(nq, nk, nv, nk_c, nv_c, p['na_rpb'])
    pool_x = pool_mixer(pz, p['pool_w'], p['pool_scale'])
    sgu_x = sgu_mixer(su, sv, p['sgu_norm_g'], p['sgu_w'], p['sgu_b'])
    out_x = merge([pool_x, diff_x, sgu_x, na_x], gz, p['w_br'], p['w_out'])
    if not with_ctx_out:
        return out_x, None
    dq_c, nq_c, pz_c, su_c, sv_c, gz_c = split_cols(hc @ w_in[:, KV_COLS:], COL_SIZES[4:])
    diff_c = diff_attend(dshape(dq_c), dshape(dk_c), vshape(dv_c), lam, lam_init, p['diff_subln_g'])
    na_c = dense_attend(nq_c, nk_c, nv_c, NA_HEADS, NA_DH)
    pool_c = pool_mixer(pz_c, p['pool_w'], p['pool_scale'])
    sgu_c = sgu_mixer(su_c, sv_c, p['sgu_norm_g'], p['sgu_w'], p['sgu_b'])
    out_c = merge([pool_c, diff_c, sgu_c, na_c], gz_c, p['w_br'], p['w_out'])
    return out_x, out_c


def ec_moe(h, router_w, w1, w3, w2):
    B, T, D = h.shape
    cap = EC_CAPACITY * T // N_EXPERTS
    aff = jax.nn.softmax((h @ router_w).astype(jnp.float32), axis=-1)
    gate, idx = lax.top_k(jnp.swapaxes(aff, 1, 2), cap)
    xs = jax.vmap(lambda hb, ib: hb[ib])(h, idx)
    hid = jax.nn.silu(jnp.einsum('becd,edf->becf', xs, w1)) * jnp.einsum('becd,edf->becf', xs, w3)
    y = jnp.einsum('becf,efd->becd', hid, w2) * gate[..., None].astype(h.dtype)
    return jax.vmap(lambda ib, yb: jnp.zeros((T, D), h.dtype).at[ib.reshape(-1)].add(yb.reshape(-1, D)))(idx, y)


def setup_inputs(seed: int = 0) -> dict:
    key = jax.random.key(seed)
    ks = jax.random.split(key, 24)
    nrm = lambda k, shape, s: jax.random.normal(k, shape, jnp.float32) * s
    D, L, E, F = D_MODEL, DEPTH, N_EXPERTS, D_EXPERT
    return {
        'x': nrm(ks[0], (BATCH, SEQ, D), 1.0),
        'c': nrm(ks[1], (BATCH, D), 1.0),
        'ctx': nrm(ks[2], (BATCH, CTX_LEN, D), 1.0),
        'c_ctx': nrm(ks[3], (D,), 1.0),
        'w_mod': nrm(ks[4], (L, D, 6 * D), 0.5 * D ** -0.5),
        'b_mod': nrm(ks[5], (L, 6 * D), 0.02),
        'norm1_g': 1.0 + nrm(ks[6], (L, D), 0.02),
        'norm2_g': 1.0 + nrm(ks[7], (L, D), 0.02),
        'w_in': nrm(ks[8], (L, D, IN_COLS), D ** -0.5),
        'pool_w': nrm(ks[9], (L, POOL_GROUPS, POOL_GC, POOL_GC), POOL_GC ** -0.5),
        'pool_scale': 1.0 + nrm(ks[10], (L, BRANCH_W), 0.1),
        'diff_lambda': nrm(ks[11], (L, 4, DIFF_DH), 0.1),
        'diff_subln_g': 1.0 + nrm(ks[12], (L, DIFF_DV), 0.02),
        'sgu_norm_g': 1.0 + nrm(ks[13], (L, BRANCH_W), 0.02),
        'sgu_w': nrm(ks[14], (L, SGU_GROUPS, SGU_CHUNK, SGU_CHUNK), SGU_CHUNK ** -0.5),
        'sgu_b': 1.0 + nrm(ks[15], (L, SGU_GROUPS, SGU_CHUNK), 0.1),
        'na_rpb': nrm(ks[16], (L, NA_HEADS, 2 * NA_WIN_R - 1, 2 * NA_WIN_C - 1), 0.1),
        'w_br': nrm(ks[17], (L, N_BRANCH, BRANCH_W, D), BRANCH_W ** -0.5),
        'w_out': nrm(ks[18], (L, D, D), D ** -0.5),
        'router_w': nrm(ks[19], (L, D, E), D ** -0.5),
        'moe_w1': nrm(ks[20], (L, E, D, F), D ** -0.5),
        'moe_w3': nrm(ks[21], (L, E, D, F), D ** -0.5),
        'moe_w2': nrm(ks[22], (L, E, F, D), F ** -0.5),
        'final_g': 1.0 + nrm(ks[23], (D,), 0.02),
    }


def reference(x, c, ctx, c_ctx, w_mod, b_mod, norm1_g, norm2_g, w_in, pool_w, pool_scale,
              diff_lambda, diff_subln_g, sgu_norm_g, sgu_w, sgu_b, na_rpb, w_br, w_out,
              router_w, moe_w1, moe_w3, moe_w2, final_g):
    T = x.shape[1]
    tabs = rope_tables(T)
    silu_c = jax.nn.silu(c)
    silu_cc = jax.nn.silu(c_ctx)
    x_lat, x_ctx = x, ctx
    for l in range(DEPTH):
        last = l == DEPTH - 1
        lam_init = 0.8 - 0.6 * math.exp(-0.3 * l)
        p = {'w_in': w_in[l], 'pool_w': pool_w[l], 'pool_scale': pool_scale[l],
             'diff_subln_g': diff_subln_g[l], 'sgu_norm_g': sgu_norm_g[l], 'sgu_w': sgu_w[l],
             'sgu_b': sgu_b[l], 'na_rpb': na_rpb[l], 'w_br': w_br[l], 'w_out': w_out[l]}
        lam = compute_lambda(diff_lambda[l], lam_init)
        sh1, sc1, g1, sh2, sc2, g2 = jnp.split(silu_c @ w_mod[l] + b_mod[l], 6, axis=-1)
        csh1, csc1, cg1, csh2, csc2, cg2 = jnp.split(silu_cc @ w_mod[l] + b_mod[l], 6, axis=-1)
        hx = modulate(rmsnorm(x_lat, norm1_g[l]), sh1[:, None], sc1[:, None])
        hc = modulate(rmsnorm(x_ctx, norm1_g[l]), csh1, csc1)
        mix_x, mix_c = token_mixer(hx, hc, tabs, p, lam, lam_init, not last)
        x_lat = x_lat + g1[:, None] * mix_x
        hx2 = modulate(rmsnorm(x_lat, norm2_g[l]), sh2[:, None], sc2[:, None])
        x_lat = x_lat + g2[:, None] * ec_moe(hx2, router_w[l], moe_w1[l], moe_w3[l], moe_w2[l])
        if not last:
            x_ctx = x_ctx + cg1 * mix_c
            hc2 = modulate(rmsnorm(x_ctx, norm2_g[l]), csh2, csc2)
            x_ctx = x_ctx + cg2 * ec_moe(hc2, router_w[l], moe_w1[l], moe_w3[l], moe_w2[l])
    return rmsnorm(x_lat, final_g)
```

```cpp
#include <hip/hip_runtime.h>
#include <hip/hip_bf16.h>
#include <cstdio>
#include <cstdint>

#ifndef MK_PER_PHASE
#define MK_PER_PHASE 0
#endif

#define LAS __attribute__((address_space(3)))
#define GAS __attribute__((address_space(1)))
typedef unsigned short bf16_t;
typedef short bf16x8 __attribute__((ext_vector_type(8)));
typedef short s16x4 __attribute__((ext_vector_type(4)));
typedef float f32x4 __attribute__((ext_vector_type(4)));
typedef float f32x16 __attribute__((ext_vector_type(16)));
typedef unsigned u32x4 __attribute__((ext_vector_type(4)));
typedef unsigned u32x2 __attribute__((ext_vector_type(2)));
typedef float f32x2_t __attribute__((ext_vector_type(2)));
typedef __bf16 bf16x2_t __attribute__((ext_vector_type(2)));

constexpr int D = 1024, BATCH = 2, SEQ = 8192, CTX = 256;
constexpr int MLAT = BATCH * SEQ, MCTX = BATCH * CTX, MROWS = MLAT + MCTX;
constexpr int INC = 8704;
constexpr int NKEY = CTX + SEQ;
constexpr int NE = 16, CAP = 1024, CAPC = 32, ESLOT = 2304;
constexpr float EPS = 1e-6f;

constexpr size_t MiB = 1u << 20;
constexpr size_t WS_CTL = 0, CTL_ZERO_BYTES = 64 * 1024;
constexpr size_t WS_SMALL = 1 * MiB;
constexpr size_t WS_SEL = 2 * MiB;
constexpr size_t WS_AFFL = 4 * MiB;
constexpr size_t WS_AFFC = 5 * MiB;
constexpr size_t WS_IDX = 5 * MiB + 256 * 1024;
constexpr size_t WS_GATE = 5 * MiB + 512 * 1024;
constexpr size_t WS_WINT = 6 * MiB;
constexpr size_t WS_WBRT = 40 * MiB;
constexpr size_t WS_WOUTT = 48 * MiB;
constexpr size_t WS_POOLT = 52 * MiB;
constexpr size_t WS_SGUW = 52 * MiB + 512 * 1024;
constexpr size_t WS_X = 53 * MiB;
constexpr size_t WS_HX = 119 * MiB;
constexpr size_t WS_DP = WS_HX;
constexpr size_t WS_SVT = WS_HX + 16896ull * 1024;
constexpr size_t WS_A = 152 * MiB;
constexpr size_t SZ16 = 16896ull * 1024;
constexpr size_t WS_QD = WS_A, WS_KD = WS_A + SZ16, WS_VD = WS_A + 2 * SZ16, WS_NQ = WS_A + 3 * SZ16, WS_NK = WS_A + 4 * SZ16, WS_NV = WS_A + 5 * SZ16;
constexpr size_t WS_MACC = WS_QD;
constexpr size_t WS_MB = WS_NK;
constexpr size_t WS_PZ = WS_A + 6 * SZ16;
constexpr size_t WS_O0 = WS_X + 33 * MiB;
constexpr size_t WS_SVTR = WS_VD;
constexpr size_t WS_SVST = WS_NV;
constexpr size_t WS_SU = WS_A + 8 * SZ16, WS_SV = WS_A + 9 * SZ16, WS_NVT = WS_A + 10 * SZ16;
constexpr size_t WS_BR = WS_A + 11 * SZ16;
constexpr size_t WS_GZ = WS_A + 15 * SZ16;
constexpr size_t WS_WINT8 = WS_GZ + 8 * SZ16;
constexpr size_t WS_HX8 = WS_WINT8 + 34 * MiB;
constexpr size_t WS_END = WS_HX8 + 17 * MiB;
constexpr size_t WS_W13T = WS_GZ;
constexpr size_t WS_W2T = WS_GZ + 64 * MiB;
constexpr size_t WS_XS = WS_A;
constexpr size_t WS_HID = WS_A + 72 * MiB;
constexpr size_t WS_Y = WS_A + 144 * MiB;
static_assert(WS_Y + 72 * MiB <= WS_GZ && WS_W2T + 32 * MiB <= WS_END, "moe alias map");
constexpr int SM_MOD = 0;
constexpr int SM_ROPE = 40960;
constexpr int SM_LAM = 48000;

__device__ __forceinline__ unsigned cvtpk(float lo, float hi) { f32x2_t v = {lo, hi}; bf16x2_t b = __builtin_convertvector(v, bf16x2_t); return __builtin_bit_cast(unsigned, b); }
typedef int i32x8 __attribute__((ext_vector_type(8)));
typedef int i32x4_t __attribute__((ext_vector_type(4)));
__device__ __forceinline__ unsigned cvt4_fp8(float a, float b, float c, float d) { int w = __builtin_amdgcn_cvt_pk_fp8_f32(a, b, 0, false); w = __builtin_amdgcn_cvt_pk_fp8_f32(c, d, w, true); return (unsigned)w; }
__device__ __forceinline__ unsigned cvt4_fp8n(float a, float b, float c, float d) { int w = __builtin_amdgcn_cvt_pk_fp8_f32(a, b, (int)__float_as_uint(a), false); w = __builtin_amdgcn_cvt_pk_fp8_f32(c, d, w, true); return (unsigned)w; }
__device__ __forceinline__ unsigned cvt4_fp8s(float a, float b, float c, float d) {
    return cvt4_fp8(__builtin_amdgcn_fmed3f(a, -448.f, 448.f), __builtin_amdgcn_fmed3f(b, -448.f, 448.f), __builtin_amdgcn_fmed3f(c, -448.f, 448.f), __builtin_amdgcn_fmed3f(d, -448.f, 448.f)); }
__device__ __forceinline__ float bf2f(unsigned short h) { return __uint_as_float(((unsigned)h) << 16); }
__device__ __forceinline__ float bflo(unsigned w) { return __uint_as_float(w << 16); }
__device__ __forceinline__ float bfhi(unsigned w) { return __uint_as_float(w & 0xffff0000u); }
__device__ __forceinline__ float wave_sum(float v) {
#pragma unroll
    for (int o = 1; o < 64; o <<= 1) v += __shfl_xor(v, o);
    return v;
}
__device__ __forceinline__ float sigmoidf_(float x) { return __builtin_amdgcn_rcpf(1.f + __expf(-x)); }
__device__ __forceinline__ float gelu_tanh(float x) { const float u = 1.5957691216057308f * (x + 0.044715f * x * x * x); return x * sigmoidf_(u); }
__device__ __forceinline__ int crow(int r, int hi) { return (r & 3) + 8 * (r >> 2) + 4 * hi; }
#define LDS_WAIT() asm volatile("s_waitcnt lgkmcnt(0)" ::: "memory")
#define VM_WAIT() asm volatile("s_waitcnt vmcnt(0)" ::: "memory")
#define SBAR() __builtin_amdgcn_sched_barrier(0)

struct Args { const float* in[24]; float* out; unsigned char* ws; int ph_lo, ph_hi; };
enum { I_X = 0, I_C, I_CTX, I_CCTX, I_WMOD, I_BMOD, I_N1G, I_N2G, I_WIN, I_POOLW, I_POOLS, I_LAMP, I_SUBLN, I_SGUG, I_SGUW, I_SGUB, I_RPB, I_WBR, I_WOUT, I_RW, I_W1, I_W3, I_W2, I_FING };

namespace pg8 {
constexpr int BM = 256, BK = 64, HALF = 128, HTB = HALF * BK * 2, STAGE_BYTES = 8 * HTB;
__host__ __device__ __forceinline__ int lds_byte(int r, int c) { const int st = (r >> 4) * 2 + (c >> 5), rr = r & 15, cc = c & 31, ob = rr * 64 + cc * 2; return st * 1024 + (ob ^ (((ob >> 9) & 1) << 5)); }
__host__ __device__ __forceinline__ void stage_rc(int b, int& R, int& C) { const int st = b / 1024, sb = b % 1024, swz = sb ^ (((sb >> 9) & 1) << 5); R = (st >> 1) * 16 + swz / 64; C = (st & 1) * 32 + (swz % 64) / 2; }
__host__ __device__ __forceinline__ int perm32(int rho) { const int n = rho >> 4, i = rho & 15; return 8 * (i >> 2) + 4 * n + (i & 3); }
struct Unit { int pm, pn, aux; const char* A; const char* B; };
__device__ __forceinline__ int xcd_remap(int L, int nwg) { const int q = nwg >> 3, r = nwg & 7, xcd = L & 7, off = L >> 3; return (xcd < r ? xcd * (q + 1) : r * (q + 1) + (xcd - r) * q) + off; }

template <class Epi, class Sched, bool ALIGN_EPI = false, bool FP8 = false, bool GATHER = false>
__device__ __forceinline__ void gemm_phase(LAS unsigned char* lds, const int K, const Sched& S, const Epi& E) {
    const int tid = threadIdx.x, wid = __builtin_amdgcn_readfirstlane(tid >> 6), lane = tid & 63, wr = wid >> 2, wc = wid & 3, fr = lane & 15, fq = lane >> 4;
    const int nt = K / BK;
    unsigned voffA[2], voffB[2];
#pragma unroll
    for (int i = 0; i < 2; ++i) { int R, C; stage_rc(tid * 16 + i * 8192, R, C); const int Rb = Epi::PERM ? ((R & ~31) + perm32(R & 31)) : R;
        voffA[i] = (unsigned)(R * K + C) * 2u; voffB[i] = (unsigned)(Rb * K + C) * 2u; }
    const size_t kstep = (size_t)(BK * 2);
    const size_t hstep = (size_t)HALF * K * 2;
    const unsigned ldsw = (unsigned)wid * 1024u;
    const int aoff = lds_byte(wr * 64 + fr, fq * 8), boff = lds_byte(wc * 32 + fr, fq * 8);
    const int aoff8a = lds_byte(wr * 64 + fr, fq * 16), boff8a = lds_byte(wc * 32 + fr, fq * 16);
#define PG8_SA(b, h) (((b) * 2 + (h)) * HTB)
#define PG8_SB(b, h) ((4 + (b) * 2 + (h)) * HTB)
#define PG8_STAGE(bufoff, gbase, voff) do { _Pragma("unroll") for (int _i = 0; _i < 2; ++_i) \
        __builtin_amdgcn_global_load_lds((const unsigned*)((const char*)(gbase) + (voff)[_i]), (LAS unsigned*)(lds + (bufoff) + ldsw + _i * 8192), 16, 0, 0); } while (0)
#define PG8_STAGE_G(bufoff, gbase, g) do { _Pragma("unroll") for (int _i = 0; _i < 2; ++_i) \
        __builtin_amdgcn_global_load_lds((const unsigned*)((const char*)(gbase) + (g)[_i]), (LAS unsigned*)(lds + (bufoff) + ldsw + _i * 8192), 16, 0, 0); } while (0)
#define PG8_GIDX(u, g) do { _Pragma("unroll") for (int _h = 0; _h < 2; ++_h) _Pragma("unroll") for (int _i = 0; _i < 2; ++_i) { int R_, C_; stage_rc(tid * 16 + _i * 8192, R_, C_); \
        int r_ = S.idx[(u).pm * 256 + _h * 128 + R_]; r_ = r_ < 0 ? 0 : (r_ > S.idx_max ? S.idx_max : r_); (g)[_h][_i] = (unsigned)r_ * (unsigned)(K * 2) + (unsigned)C_ * 2u; } } while (0)
#define PG8_LDA(dst, b, h) do { if constexpr (FP8) { _Pragma("unroll") for (int m = 0; m < 4; ++m) { const u32x4 x0_ = *(const LAS u32x4*)(lds + PG8_SA(b, h) + aoff8a + m * 2048), x1_ = *(const LAS u32x4*)(lds + PG8_SA(b, h) + aoff8a + 16 + m * 2048); \
        dst##8[m] = __builtin_bit_cast(i32x8, __builtin_shufflevector(x0_, x1_, 0, 1, 2, 3, 4, 5, 6, 7)); } } else { \
        _Pragma("unroll") for (int m = 0; m < 4; ++m) _Pragma("unroll") for (int k = 0; k < 2; ++k) dst[m][k] = *(const LAS bf16x8*)(lds + PG8_SA(b, h) + aoff + m * 2048 + k * 1024); } } while (0)
#define PG8_LDB(dst, b, h) do { if constexpr (FP8) { _Pragma("unroll") for (int n = 0; n < 2; ++n) { const u32x4 x0_ = *(const LAS u32x4*)(lds + PG8_SB(b, h) + boff8a + n * 2048), x1_ = *(const LAS u32x4*)(lds + PG8_SB(b, h) + boff8a + 16 + n * 2048); \
        dst##8[n] = __builtin_bit_cast(i32x8, __builtin_shufflevector(x0_, x1_, 0, 1, 2, 3, 4, 5, 6, 7)); } } else { \
        _Pragma("unroll") for (int n = 0; n < 2; ++n) _Pragma("unroll") for (int k = 0; k < 2; ++k) dst[n][k] = *(const LAS bf16x8*)(lds + PG8_SB(b, h) + boff + n * 2048 + k * 1024); } } while (0)
#define PG8_MMA(ai, bj, At, Bt) do { __builtin_amdgcn_s_setprio(1); if constexpr (FP8) { _Pragma("unroll") for (int m = 0; m < 4; ++m) _Pragma("unroll") for (int n = 0; n < 2; ++n) \
        asm("v_mfma_scale_f32_16x16x128_f8f6f4 %0, %1, %2, %0, %3, %3 op_sel_hi:[0,0,0]" : "+v"(acc[ai][bj][m][n]) : "v"(Bt##8[n]), "v"(At##8[m]), "v"(mxs)); } else { \
        _Pragma("unroll") for (int m = 0; m < 4; ++m) _Pragma("unroll") for (int n = 0; n < 2; ++n) _Pragma("unroll") for (int k = 0; k < 2; ++k) \
        acc[ai][bj][m][n] = __builtin_amdgcn_mfma_f32_16x16x32_bf16(Bt[n][k], At[m][k], acc[ai][bj][m][n], 0, 0, 0); } __builtin_amdgcn_s_setprio(0); } while (0)
#define PG8_WAIT_V(n) asm volatile("s_waitcnt vmcnt(" #n ")" ::: "memory")
#define PG8_WAIT_L(n) asm volatile("s_waitcnt lgkmcnt(" #n ")" ::: "memory")
#define PG8_BAR __builtin_amdgcn_s_barrier()
#define PG8_SCHED __builtin_amdgcn_sched_barrier(0)
    Unit cur, nxt; int ui = 0;
    if (!S.next(0, cur)) return;
    f32x4 acc[2][2][4][2];
#pragma unroll
    for (int a = 0; a < 2; ++a)
#pragma unroll
        for (int b = 0; b < 2; ++b)
#pragma unroll
            for (int m = 0; m < 4; ++m)
#pragma unroll
                for (int n = 0; n < 2; ++n) acc[a][b][m][n] = (f32x4){0.f, 0.f, 0.f, 0.f};
    bf16x8 At[4][2], B0[2][2], B1[2][2]; i32x8 At8[4], B08[2], B18[2]; const int mxs = 0x7F7F7F7F;
    const char* cA = cur.A; const char* cB = cur.B;
    unsigned gA[2][2], gN[2][2]; if constexpr (GATHER) { PG8_GIDX(cur, gA); }
    PG8_STAGE(PG8_SB(0, 0), cB, voffB); PG8_STAGE(PG8_SB(0, 1), cB + hstep, voffB);
    if constexpr (GATHER) { PG8_STAGE_G(PG8_SA(0, 0), cA, gA[0]); PG8_STAGE_G(PG8_SA(0, 1), cA, gA[1]); } else { PG8_STAGE(PG8_SA(0, 0), cA, voffA); PG8_STAGE(PG8_SA(0, 1), cA + hstep, voffA); }
    if (wr == 1) PG8_BAR;
    PG8_WAIT_V(2); PG8_BAR;
    PG8_STAGE(PG8_SB(1, 0), cB + kstep, voffB); if constexpr (GATHER) PG8_STAGE_G(PG8_SA(1, 0), cA + kstep, gA[0]); else PG8_STAGE(PG8_SA(1, 0), cA + kstep, voffA); PG8_STAGE(PG8_SB(1, 1), cB + hstep + kstep, voffB);
    PG8_WAIT_V(6); PG8_BAR;
    for (;;) {
        const bool has_next = S.next(ui + 1, nxt);
        const char* nA = has_next ? nxt.A : cA; const char* nB = has_next ? nxt.B : cB;
        if constexpr (GATHER) { if (has_next) { PG8_GIDX(nxt, gN); } else { gN[0][0] = gA[0][0]; gN[0][1] = gA[0][1]; gN[1][0] = gA[1][0]; gN[1][1] = gA[1][1]; } }
#pragma nounroll
        for (int t = 0; t < nt; t += 2) {
            const bool last = (t == nt - 2);
            const char* a1 = cA + (size_t)(t + 1) * kstep;
            const char* a2 = last ? nA : cA + (size_t)(t + 2) * kstep; const char* b2 = last ? nB : cB + (size_t)(t + 2) * kstep;
            const char* a3 = a2 + kstep; const char* b3 = b2 + kstep;
            unsigned g0_[2], g1_[2]; if constexpr (GATHER) { g0_[0] = last ? gN[0][0] : gA[0][0]; g0_[1] = last ? gN[0][1] : gA[0][1]; g1_[0] = last ? gN[1][0] : gA[1][0]; g1_[1] = last ? gN[1][1] : gA[1][1]; }
            PG8_LDB(B0, 0, 0); PG8_LDB(B1, 0, 1); PG8_SCHED; PG8_LDA(At, 0, 0); if constexpr (GATHER) PG8_STAGE_G(PG8_SA(1, 1), a1, gA[1]); else PG8_STAGE(PG8_SA(1, 1), a1 + hstep, voffA);
            PG8_WAIT_V(8); PG8_WAIT_L(0); PG8_BAR; PG8_MMA(0, 0, At, B0); PG8_MMA(0, 1, At, B1); PG8_BAR; PG8_SCHED;
            PG8_LDA(At, 0, 1); PG8_STAGE(PG8_SB(0, 0), b2, voffB); PG8_STAGE(PG8_SB(0, 1), b2 + hstep, voffB); if constexpr (GATHER) PG8_STAGE_G(PG8_SA(0, 0), a2, g0_); else PG8_STAGE(PG8_SA(0, 0), a2, voffA);
            PG8_WAIT_V(8); PG8_WAIT_L(0); PG8_BAR; PG8_MMA(1, 0, At, B0); PG8_MMA(1, 1, At, B1); PG8_BAR; PG8_SCHED;
            PG8_LDB(B0, 1, 0); PG8_LDB(B1, 1, 1); PG8_SCHED; PG8_LDA(At, 1, 0); if constexpr (GATHER) PG8_STAGE_G(PG8_SA(0, 1), a2, g1_); else PG8_STAGE(PG8_SA(0, 1), a2 + hstep, voffA);
            PG8_WAIT_V(8); PG8_WAIT_L(0); PG8_BAR; PG8_MMA(0, 0, At, B0); PG8_MMA(0, 1, At, B1); PG8_BAR; PG8_SCHED;
            PG8_LDA(At, 1, 1); PG8_STAGE(PG8_SB(1, 0), b3, voffB); PG8_STAGE(PG8_SB(1, 1), b3 + hstep, voffB); if constexpr (GATHER) PG8_STAGE_G(PG8_SA(1, 0), a3, g0_); else PG8_STAGE(PG8_SA(1, 0), a3, voffA);
            PG8_WAIT_V(8); PG8_WAIT_L(0); PG8_BAR; PG8_MMA(1, 0, At, B0); PG8_MMA(1, 1, At, B1); PG8_BAR; PG8_SCHED;
        }
        if constexpr (ALIGN_EPI) { if (wr == 0) PG8_BAR; }
        if constexpr (FP8) asm volatile("s_nop 15\n\ts_nop 15" ::: "memory");
        { int t2 = threadIdx.x; asm volatile("" : "+v"(t2)); const int fr2 = t2 & 15, fq2 = (t2 & 63) >> 4; E(acc, cur, wr, wc, fr2, fq2); }
        if (!has_next) break;
        if (!E.keep(cur)) {
#pragma unroll
        for (int a = 0; a < 2; ++a)
#pragma unroll
            for (int b = 0; b < 2; ++b)
#pragma unroll
                for (int m = 0; m < 4; ++m)
#pragma unroll
                    for (int n = 0; n < 2; ++n) acc[a][b][m][n] = (f32x4){0.f, 0.f, 0.f, 0.f};
        }
        cur = nxt; cA = nA; cB = nB; ++ui;
        if constexpr (GATHER) { gA[0][0] = gN[0][0]; gA[0][1] = gN[0][1]; gA[1][0] = gN[1][0]; gA[1][1] = gN[1][1]; }
        if constexpr (ALIGN_EPI) { if (wr == 1) PG8_BAR; }
    }
    PG8_WAIT_V(0);
    if constexpr (!ALIGN_EPI) { if (wr == 0) PG8_BAR; }
    PG8_BAR;
#undef PG8_SA
#undef PG8_SB
#undef PG8_STAGE
#undef PG8_STAGE_G
#undef PG8_GIDX
#undef PG8_LDA
#undef PG8_LDB
#undef PG8_MMA
#undef PG8_WAIT_V
#undef PG8_WAIT_L
#undef PG8_BAR
#undef PG8_SCHED
}
}
using pg8::Unit;
typedef f32x4 AccT[2][2][4][2];

#ifndef WIN_FP8_MASK
#define WIN_FP8_MASK 0x3FFFC0FFFull
#endif
struct WinOrder {
    int G, c, ncn, sel, rev; const char* A; const char* B; size_t tb;
    __device__ __forceinline__ int pn_of(int k, int lim) const { int q = -1; for (int p = 0; p < lim; ++p) { if ((int)((WIN_FP8_MASK >> p) & 1ull) == sel) { if (++q == k) return p; } } return 0; }
    __device__ __forceinline__ int count(int lim) const { int q = 0; for (int p = 0; p < lim; ++p) q += ((int)((WIN_FP8_MASK >> p) & 1ull) == sel) ? 1 : 0; return q; }
    __device__ __forceinline__ bool next(int i, Unit& u) const {
        const int cc = rev ? G - 1 - c : c; const int L = i * G + cc; const int n = count(34), nc = count(ncn); const int nlat = 64 * n;
        int k;
        if (L < nlat) { const int wgid = pg8::xcd_remap(L, nlat); const int nig = 8 * n, gid = wgid / nig, rem = wgid % nig; u.pm = gid * 8 + (rem & 7); k = rem >> 3; u.pn = pn_of(k, 34); }
        else if (L < nlat + 2 * nc) { const int Lc = L - nlat; u.pm = 64 + (Lc & 1); k = Lc >> 1; u.pn = pn_of(k, ncn); }
        else return false;
        u.aux = 0; u.A = A + (size_t)u.pm * tb; u.B = B + (size_t)u.pn * tb; return true;
    }
};
struct MergeOrder {
    int G, c, nM; const char* A; const char* B; const char* A0;
    __device__ __forceinline__ bool next(int i, Unit& u) const {
        const int j = i >> 2, br = i & 3; const int L = j * G + c, nwg = nM * 4; if (L >= nwg) return false;
        const int wgid = pg8::xcd_remap(L, nwg); u.pm = wgid >> 2; u.pn = wgid & 3; u.aux = br;
        u.A = (br == 0 ? A0 : A + (size_t)br * ((size_t)MROWS * 512 * 2)) + (size_t)u.pm * (256 * 512 * 2); u.B = B + (size_t)br * (1024 * 512 * 2) + (size_t)u.pn * (256 * 512 * 2); return true;
    }
};
struct WoutOrder {
    int G, c, nM; const char* A; const char* B;
    __device__ __forceinline__ bool next(int i, Unit& u) const {
        const int L = i * G + c, nwg = nM * 4; if (L >= nwg) return false;
        const int wgid = pg8::xcd_remap(L, nwg); u.pm = wgid >> 2; u.pn = wgid & 3; u.aux = 0;
        u.A = A + (size_t)u.pm * (256 * 1024 * 2); u.B = B + (size_t)u.pn * (256 * 1024 * 2); return true;
    }
};
struct MoeOrder {
    int G, c, nMe, nNe; const char* A; const char* B; size_t tb; const int* idx; int idx_max;
    __device__ __forceinline__ bool next(int i, Unit& u) const {
        const int L = i * G + c, per = nMe * nNe, nwg = NE * per; if (L >= nwg) return false;
        const int wgid = pg8::xcd_remap(L, nwg); const int e = wgid / per, rem = wgid % per; const int pmi = rem / nNe, pnj = rem % nNe;
        u.pm = e * 9 + pmi; u.pn = e * nNe + pnj; u.aux = e;
        u.A = idx ? A : A + (size_t)u.pm * tb; u.B = B + (size_t)u.pn * tb; return true;
    }
};

constexpr size_t NV8T_OFF = (size_t)8 * 128 * NKEY;
struct EpiWin {
    __device__ __forceinline__ bool keep(const Unit&) const { return false; }
    static constexpr bool PERM = true;
    bf16_t *QD, *KD, *VD, *NQ, *NK, *NV, *SU, *SV, *GZ; bf16_t* PZ;        const float* ROPE; float ascale; unsigned char* V8T_;
    template <int TYPE> __device__ __forceinline__ void run(AccT& acc, const Unit& u, int wr, int wc, int fr, int fq) const {
        const int pm = u.pm, pn = u.pn; const bool isctx = pm >= 64;
        const int b = isctx ? pm - 64 : pm >> 5, t0 = isctx ? 0 : (pm & 31) * 256, key0 = isctx ? 0 : CTX;
        const int cbase = (TYPE == 9) ? (pn - 18) * 256 : (pn & 1) * 256, cw = wc * 32 + 8 * fq;
#pragma unroll
        for (int ai = 0; ai < 2; ++ai)
#pragma unroll
            for (int m = 0; m < 4; ++m) {
                const int rl = wr * 64 + fr + ai * 128 + m * 16; const size_t row = (size_t)pm * 256 + rl; const int t = t0 + rl;
                float st1 = 0.f, st2 = 0.f;
#pragma unroll
                for (int bj = 0; bj < 2; ++bj) {
                    const int c = cbase + bj * 128 + cw;
                    float v[8];
#pragma unroll
                    for (int j = 0; j < 4; ++j) { v[j] = acc[ai][bj][m][0][j] * ascale; v[4 + j] = acc[ai][bj][m][1][j] * ascale; }
                    if constexpr (TYPE == 0 || TYPE == 4) {
                        if (!isctx) {
                            const int part = wc & 1, pos = part ? (t & 63) : (t >> 6);
                            const float* cp = ROPE + (part ? 4096 : 0) + pos * 16 + (fq & 1) * 8; const float* sp = cp + (part ? 1024 : 2048);
                            const f32x4 c0 = *(const f32x4*)cp, c1 = *(const f32x4*)(cp + 4), s0 = *(const f32x4*)sp, s1 = *(const f32x4*)(sp + 4);
                            const float sg = (fq < 2) ? -1.f : 1.f;
#pragma unroll
                            for (int j = 0; j < 8; ++j) { const float pv = __shfl_xor(v[j], 32); const float cc = j < 4 ? c0[j & 3] : c1[j & 3], ss = j < 4 ? s0[j & 3] : s1[j & 3]; v[j] = v[j] * cc + pv * (sg * ss); }
                        }
                        unsigned char* dst = (unsigned char*)(TYPE == 0 ? KD : QD) + ((size_t)((b * 4 + (c >> 7)) * 2 + ((c >> 6) & 1)) * NKEY + key0 + t) * 64 + (c & 63);
                        if constexpr (TYPE == 4) {
#pragma unroll
                            for (int j = 0; j < 8; ++j) v[j] *= 1.4426950408889634f;
                        }
                        *(u32x2*)dst = (u32x2){cvt4_fp8s(v[0], v[1], v[2], v[3]), cvt4_fp8s(v[4], v[5], v[6], v[7])};
                    } else if constexpr (TYPE == 1) {
                        unsigned char* dst = V8T_ + ((size_t)(b * 4 + (c >> 7)) * 128 + (c & 127)) * NKEY + key0 + t;
                        const unsigned w0 = cvt4_fp8s(v[0], v[1], v[2], v[3]), w1 = cvt4_fp8s(v[4], v[5], v[6], v[7]);
#pragma unroll
                        for (int j = 0; j < 8; ++j) dst[(size_t)j * NKEY] = (unsigned char)(((j < 4 ? w0 : w1) >> (8 * (j & 3))) & 255u);
                    } else if constexpr (TYPE == 6) {
                        *(u32x4*)(PZ + row * 512 + c) = (u32x4){cvtpk(v[0], v[1]), cvtpk(v[2], v[3]), cvtpk(v[4], v[5]), cvtpk(v[6], v[7])};
                    } else if constexpr (TYPE == 9) {
                        unsigned w0 = 0u, w1 = 0u; const float ne = -ascale * 1.4426950408889634f;
#pragma unroll
                        for (int j = 0; j < 4; ++j) {
                            const float y0 = fmaxf(fmaf(__builtin_amdgcn_rcpf(1.f + __builtin_amdgcn_exp2f(acc[ai][bj][m][0][j] * ne)), 255.f, 0.5f), 1.f), y1 = fmaxf(fmaf(__builtin_amdgcn_rcpf(1.f + __builtin_amdgcn_exp2f(acc[ai][bj][m][1][j] * ne)), 255.f, 0.5f), 1.f);
                            w0 = __builtin_amdgcn_cvt_pk_u8_f32(y0, j, w0); w1 = __builtin_amdgcn_cvt_pk_u8_f32(y1, j, w1); }
                        *(u32x2*)((unsigned char*)GZ + ((size_t)(c >> 5) * MROWS + row) * 32 + (c & 31)) = (u32x2){w0, w1};
                    } else if constexpr (TYPE == 2 || TYPE == 5) {
                        if constexpr (TYPE == 5) {
#pragma unroll
                            for (int j = 0; j < 8; ++j) v[j] *= 1.4426950408889634f;
                        }
                        *(u32x2*)((unsigned char*)(TYPE == 2 ? NK : NQ) + row * 512 + c) = (u32x2){cvt4_fp8s(v[0], v[1], v[2], v[3]), cvt4_fp8s(v[4], v[5], v[6], v[7])};
                    } else if constexpr (TYPE == 3) {
                        unsigned char* dst = V8T_ + NV8T_OFF + (size_t)c * MROWS + row;
                        const unsigned w0 = cvt4_fp8s(v[0], v[1], v[2], v[3]), w1 = cvt4_fp8s(v[4], v[5], v[6], v[7]);
#pragma unroll
                        for (int j = 0; j < 8; ++j) dst[(size_t)j * MROWS] = (unsigned char)(((j < 4 ? w0 : w1) >> (8 * (j & 3))) & 255u);
                    } else {
                        if constexpr (TYPE == 7 || TYPE == 8) {
#pragma unroll
                            for (int j = 0; j < 8; ++j) v[j] = gelu_tanh(v[j]);
                        }
                        if constexpr (TYPE == 8) {
                            bf16_t* dst = VD + (size_t)c * MROWS + row;
#pragma unroll
                            for (int j = 0; j < 8; ++j) { const unsigned hb = cvtpk(v[j], 0.f) & 0xffffu; const float vr = __uint_as_float(hb << 16); st1 += vr; st2 += vr * vr; dst[(size_t)j * MROWS] = (bf16_t)hb; }
                        } else {
                        bf16_t* base = TYPE == 7 ? SU : SV;
                        *(u32x4*)(base + row * 512 + c) = (u32x4){cvtpk(v[0], v[1]), cvtpk(v[2], v[3]), cvtpk(v[4], v[5]), cvtpk(v[6], v[7])};
                        }
                    }
                }
                if constexpr (TYPE == 8) {
                    st1 += __shfl_xor(st1, 16); st2 += __shfl_xor(st2, 16); st1 += __shfl_xor(st1, 32); st2 += __shfl_xor(st2, 32);
                    if (fq == 0) *(f32x2_t*)((float*)NV + (row * 8 + (pn & 1) * 4 + wc) * 2) = (f32x2_t){st1, st2};
                }
            }
    }
    __device__ __forceinline__ void operator()(AccT& acc, const Unit& u, int wr, int wc, int fr, int fq) const {
#ifdef EPIWIN_ONLY
        const int ty = EPIWIN_ONLY;
#else
        const int ty = u.pn < 18 ? (u.pn >> 1) : 9;
#endif
        switch (ty) {
            case 0: run<0>(acc, u, wr, wc, fr, fq); break; case 1: run<1>(acc, u, wr, wc, fr, fq); break; case 2: run<2>(acc, u, wr, wc, fr, fq); break;
            case 3: run<3>(acc, u, wr, wc, fr, fq); break; case 4: run<4>(acc, u, wr, wc, fr, fq); break; case 5: run<5>(acc, u, wr, wc, fr, fq); break;
            case 6: run<6>(acc, u, wr, wc, fr, fq); break; case 7: run<7>(acc, u, wr, wc, fr, fq); break; case 8: run<8>(acc, u, wr, wc, fr, fq); break;
            default: run<9>(acc, u, wr, wc, fr, fq); break;
        }
    }
};
struct EpiMerge {
    static constexpr bool PERM = true;
    const bf16_t* GZ; bf16_t* MB;
    __device__ __forceinline__ bool keep(const Unit& u) const { return u.aux < 3; }
    __device__ __forceinline__ void operator()(AccT& acc, const Unit& u, int wr, int wc, int fr, int fq) const {
        const int br = u.aux;
#pragma unroll
        for (int ai = 0; ai < 2; ++ai)
#pragma unroll
            for (int m = 0; m < 4; ++m) {
                const size_t row = (size_t)u.pm * 256 + wr * 64 + fr + ai * 128 + m * 16;
#pragma unroll
                for (int bj = 0; bj < 2; ++bj) {
                    const int col = u.pn * 256 + bj * 128 + wc * 32 + 8 * fq;
                    const unsigned char* gp = (const unsigned char*)GZ + ((size_t)(br * 32 + (col >> 5)) * MROWS + row) * 32 + (col & 31);
                    const u32x2 gw = *(const u32x2*)gp;
                    float g[8];
#pragma unroll
                    for (int q = 0; q < 8; ++q) g[q] = (float)(((q < 4 ? gw.x : gw.y) >> (8 * (q & 3))) & 255u);
                    if (br < 3) {
                        const u32x2 hw = *(const u32x2*)(gp + (size_t)32 * MROWS * 32);
#pragma unroll
                        for (int q = 0; q < 8; ++q) { const float h = (float)(((q < 4 ? hw.x : hw.y) >> (8 * (q & 3))) & 255u); acc[ai][bj][m][q >> 2][q & 3] *= g[q] * __builtin_amdgcn_rcpf(h); }
                    } else {
                        float v[8];
#pragma unroll
                        for (int q = 0; q < 8; ++q) v[q] = acc[ai][bj][m][q >> 2][q & 3] * (g[q] * (1.f / 255.f));
                        *(u32x4*)(MB + row * 1024 + col) = (u32x4){cvtpk(v[0], v[1]), cvtpk(v[2], v[3]), cvtpk(v[4], v[5]), cvtpk(v[6], v[7])};
                    }
                }
            }
    }
};
struct EpiWout {
    __device__ __forceinline__ bool keep(const Unit&) const { return false; }
    static constexpr bool PERM = true;
    const float* xlat; const float* xctx; bf16_t* X; const float* MODL; int first;
    __device__ __forceinline__ void operator()(AccT& acc, const Unit& u, int wr, int wc, int fr, int fq) const {
        const bool isctx = u.pm >= 64; const int mr = isctx ? 2 : (u.pm >> 5);
#pragma unroll
        for (int bj = 0; bj < 2; ++bj) {
            const int col = u.pn * 256 + bj * 128 + wc * 32 + 8 * fq;
            const f32x4 g0 = *(const f32x4*)(MODL + mr * 6144 + 2048 + col), g1 = *(const f32x4*)(MODL + mr * 6144 + 2048 + col + 4);
#pragma unroll
            for (int ai = 0; ai < 2; ++ai)
#pragma unroll
                for (int m = 0; m < 4; ++m) {
                    const size_t row = (size_t)u.pm * 256 + wr * 64 + fr + ai * 128 + m * 16;
                    f32x4 x0, x1;
                    if (first) { const float* src = (isctx ? xctx + (row - MLAT) * 1024 : xlat + row * 1024) + col; x0 = *(const f32x4*)src; x1 = *(const f32x4*)(src + 4); }
                    else { const u32x4 w = *(const u32x4*)(X + row * 1024 + col); x0 = (f32x4){bflo(w.x), bfhi(w.x), bflo(w.y), bfhi(w.y)}; x1 = (f32x4){bflo(w.z), bfhi(w.z), bflo(w.w), bfhi(w.w)}; }
                    x0 += g0 * acc[ai][bj][m][0]; x1 += g1 * acc[ai][bj][m][1];
                    *(u32x4*)(X + row * 1024 + col) = (u32x4){cvtpk(x0.x, x0.y), cvtpk(x0.z, x0.w), cvtpk(x1.x, x1.y), cvtpk(x1.z, x1.w)};
                }
        }
    }
};
struct EpiW13 {
    __device__ __forceinline__ bool keep(const Unit&) const { return false; }
    static constexpr bool PERM = true;
    unsigned char* HID;
    __device__ __forceinline__ void operator()(AccT& acc, const Unit& u, int wr, int wc, int fr, int fq) const {
        const int j = u.pn & 7;
#pragma unroll
        for (int ai = 0; ai < 2; ++ai)
#pragma unroll
            for (int m = 0; m < 4; ++m) {
                const size_t row = (size_t)u.pm * 256 + wr * 64 + fr + ai * 128 + m * 16;
                float h[8];
#pragma unroll
                for (int q = 0; q < 8; ++q) { const float a1 = acc[ai][0][m][q >> 2][q & 3], a3 = acc[ai][1][m][q >> 2][q & 3];
                    h[q] = (a1 * a3) * (__builtin_amdgcn_rcpf(1.f + __builtin_amdgcn_exp2f(a1 * (-1.4426950408889634f / 32.f))) * (4.f / 1024.f)); }
                *(u32x2*)(HID + row * 1024 + j * 128 + wc * 32 + 8 * fq) = (u32x2){cvt4_fp8s(h[0], h[1], h[2], h[3]), cvt4_fp8s(h[4], h[5], h[6], h[7])};
            }
    }
};
struct EpiW2 {
    __device__ __forceinline__ bool keep(const Unit&) const { return false; }
    static constexpr bool PERM = true;
    unsigned char* Y; const float* GATE;
    __device__ __forceinline__ void operator()(AccT& acc, const Unit& u, int wr, int wc, int fr, int fq) const {
        const int j = u.pn & 3;
#pragma unroll
        for (int ai = 0; ai < 2; ++ai)
#pragma unroll
            for (int m = 0; m < 4; ++m) {
                const size_t row = (size_t)u.pm * 256 + wr * 64 + fr + ai * 128 + m * 16;
                const float g = GATE[row];
#pragma unroll
                for (int bj = 0; bj < 2; ++bj) {
                    const f32x4 v0 = acc[ai][bj][m][0] * g, v1 = acc[ai][bj][m][1] * g;
                    *(u32x2*)(Y + row * 1024 + j * 256 + bj * 128 + wc * 32 + 8 * fq) = (u32x2){cvt4_fp8s(v0[0], v0[1], v0[2], v0[3]), cvt4_fp8s(v1[0], v1[1], v1[2], v1[3])};
                }
            }
    }
};

namespace dattn {
constexpr int NW = 8, QBLK = 32, KVBLK = 64;
constexpr float SCALE = 0.125f;
constexpr float THR = 8.f;
constexpr int SHM_V = KVBLK * 128 * 2, SHM_K = KVBLK * 64 * 2;
constexpr int LDS_BYTES = 2 * SHM_V + 2 * SHM_K + NW * 64 * 4;
#define KSWZ64(row, colB) ((row) * 128 + ((colB) ^ ((((row) >> 1) & 7) << 4)))
template <int VAR> __device__ __forceinline__ void partialSM(f32x16& p0, f32x16& p1, float& m_reg, float& mn, float& alpha) {
    constexpr float C = SCALE * 1.4426950408889634f;
    float pmax = p0[0];
    if constexpr (VAR != 1) {
#pragma unroll
    for (int r = 1; r < 16; ++r) pmax = fmaxf(pmax, p0[r]);
#pragma unroll
    for (int r = 0; r < 16; ++r) pmax = fmaxf(pmax, p1[r]);
    } else pmax = m_reg;
    { auto rr = __builtin_amdgcn_permlane32_swap(__float_as_uint(pmax), __float_as_uint(pmax), false, false); pmax = fmaxf(__uint_as_float(rr[0]), __uint_as_float(rr[1])); }
    if (__builtin_expect(__all(pmax - m_reg <= THR / SCALE), 1)) { mn = m_reg; alpha = 1.f; }
    else { mn = fmaxf(m_reg, pmax); alpha = __builtin_amdgcn_exp2f((m_reg - mn) * C); m_reg = mn; }
    const float mnC = -mn * C;
#pragma unroll
    for (int r = 0; r < 16; ++r) p0[r] = fmaf(p0[r], C, mnC);
#pragma unroll
    for (int r = 0; r < 16; ++r) p1[r] = fmaf(p1[r], C, mnC);
#pragma unroll
    for (int r = 0; r < 16; ++r) p0[r] = (VAR == 2) ? p0[r] * 0.001f : __builtin_amdgcn_exp2f(p0[r]);
}
#define PK4(P, BASE, OUT) do { unsigned a0 = cvtpk(P[BASE + 0], P[BASE + 1]), a1 = cvtpk(P[BASE + 2], P[BASE + 3]);   \
    unsigned b0 = cvtpk(P[BASE + 4], P[BASE + 5]), b1 = cvtpk(P[BASE + 6], P[BASE + 7]);                              \
    auto r0 = __builtin_amdgcn_permlane32_swap(a0, b0, false, false); auto r1 = __builtin_amdgcn_permlane32_swap(a1, b1, false, false); \
    u32x4 w = {r0[0], r1[0], r0[1], r1[1]}; OUT = __builtin_bit_cast(bf16x8, w); } while (0)
template <int VAR> __device__ __forceinline__ void finishSM(f32x16& p0, f32x16& p1, float alpha, float& l_reg, bf16x8& pa0, bf16x8& pa1, bf16x8& pa2, bf16x8& pa3) {
#pragma unroll
    for (int r = 0; r < 16; ++r) p1[r] = (VAR == 2) ? p1[r] * 0.001f : __builtin_amdgcn_exp2f(p1[r]);
    float ps = 0;
#pragma unroll
    for (int r = 0; r < 16; ++r) ps += p0[r];
#pragma unroll
    for (int r = 0; r < 16; ++r) ps += p1[r];
    { auto rr = __builtin_amdgcn_permlane32_swap(__float_as_uint(ps), __float_as_uint(ps), false, false); ps = __uint_as_float(rr[0]) + __uint_as_float(rr[1]); }
    l_reg = l_reg * alpha + ps;
    PK4(p0, 0, pa0); PK4(p0, 8, pa1); PK4(p1, 0, pa2); PK4(p1, 8, pa3);
}
template <int VAR> __device__ __forceinline__ void qkt(f32x16& p0, f32x16& p1, const char* Ks, const bf16x8* qr, int r32, int hi) {
    p0 = f32x16{}; p1 = f32x16{};
    if constexpr (VAR == 4) { const float qv = __builtin_bit_cast(float, (int)qr[0][0] << 16); for (int r = 0; r < 16; ++r) { p0[r] = qv * (float)r; p1[r] = qv; } return; }
#pragma unroll
    for (int d0 = 0; d0 < 4; ++d0) { const int cb = (d0 * 16 + hi * 8) * 2;
        const bf16x8 b0 = *reinterpret_cast<const bf16x8*>(Ks + KSWZ64(r32, cb));
        const bf16x8 b1 = *reinterpret_cast<const bf16x8*>(Ks + KSWZ64(32 + r32, cb));
        p0 = __builtin_amdgcn_mfma_f32_32x32x16_bf16(b0, qr[d0], p0, 0, 0, 0);
        p1 = __builtin_amdgcn_mfma_f32_32x32x16_bf16(b1, qr[d0], p1, 0, 0, 0); }
}
__device__ __forceinline__ int v_st(int k, int c) { const int kk = (k & ~0xC) | ((k & 4) << 1) | ((k & 8) >> 1); return ((kk >> 3) * 4 + (c >> 5)) * 512 + ((kk & 7) * 32 + (c & 31)) * 2; }
__device__ __forceinline__ int v_rd_base(int lane) { return ((lane & 3) << 3) | (((lane >> 2) & 3) << 6) | (((lane >> 4) & 1) << 5) | (((lane >> 5) & 1) << 8); }
constexpr int v_rd_off(int d0, int ks, int half) { return d0 * 512 + ks * 4096 + half * 2048; }
template <int OFF> __device__ __forceinline__ s16x4 tr_read(int vb) { s16x4 r; asm volatile("ds_read_b64_tr_b16 %0, %1 offset:%2" : "=&v"(r) : "v"(vb), "i"(OFF) : "memory"); return r; }
template <int D0> __device__ __forceinline__ void pv_one(f32x16& od, int vb, bf16x8 pa0, bf16x8 pa1, bf16x8 pa2, bf16x8 pa3) {
    const s16x4 l0 = tr_read<v_rd_off(D0, 0, 0)>(vb), h0 = tr_read<v_rd_off(D0, 0, 1)>(vb), l1 = tr_read<v_rd_off(D0, 1, 0)>(vb), h1 = tr_read<v_rd_off(D0, 1, 1)>(vb);
    const s16x4 l2 = tr_read<v_rd_off(D0, 2, 0)>(vb), h2 = tr_read<v_rd_off(D0, 2, 1)>(vb), l3 = tr_read<v_rd_off(D0, 3, 0)>(vb), h3 = tr_read<v_rd_off(D0, 3, 1)>(vb);
    asm volatile("s_waitcnt lgkmcnt(0)" ::: "memory"); SBAR();
#define PKV(L, H) (bf16x8){L[0], L[1], L[2], L[3], H[0], H[1], H[2], H[3]}
    od = __builtin_amdgcn_mfma_f32_32x32x16_bf16(pa0, PKV(l0, h0), od, 0, 0, 0);
    od = __builtin_amdgcn_mfma_f32_32x32x16_bf16(pa1, PKV(l1, h1), od, 0, 0, 0);
    od = __builtin_amdgcn_mfma_f32_32x32x16_bf16(pa2, PKV(l2, h2), od, 0, 0, 0);
    od = __builtin_amdgcn_mfma_f32_32x32x16_bf16(pa3, PKV(l3, h3), od, 0, 0, 0);
#undef PKV
}
template <int D0> __device__ __forceinline__ void pv_rd(s16x4 (&v)[8], int vb) {
    v[0] = tr_read<v_rd_off(D0, 0, 0)>(vb); v[1] = tr_read<v_rd_off(D0, 0, 1)>(vb); v[2] = tr_read<v_rd_off(D0, 1, 0)>(vb); v[3] = tr_read<v_rd_off(D0, 1, 1)>(vb);
    v[4] = tr_read<v_rd_off(D0, 2, 0)>(vb); v[5] = tr_read<v_rd_off(D0, 2, 1)>(vb); v[6] = tr_read<v_rd_off(D0, 3, 0)>(vb); v[7] = tr_read<v_rd_off(D0, 3, 1)>(vb);
}
__device__ __forceinline__ void pv_mm(f32x16& od, const s16x4 (&v)[8], bf16x8 pa0, bf16x8 pa1, bf16x8 pa2, bf16x8 pa3) {
#define PKV(L, H) (bf16x8){L[0], L[1], L[2], L[3], H[0], H[1], H[2], H[3]}
    od = __builtin_amdgcn_mfma_f32_32x32x16_bf16(pa0, PKV(v[0], v[1]), od, 0, 0, 0);
    od = __builtin_amdgcn_mfma_f32_32x32x16_bf16(pa1, PKV(v[2], v[3]), od, 0, 0, 0);
    od = __builtin_amdgcn_mfma_f32_32x32x16_bf16(pa2, PKV(v[4], v[5]), od, 0, 0, 0);
    od = __builtin_amdgcn_mfma_f32_32x32x16_bf16(pa3, PKV(v[6], v[7]), od, 0, 0, 0);
#undef PKV
}
__device__ __forceinline__ void pv_pipe(f32x16* o, int vb, bf16x8 pa0, bf16x8 pa1, bf16x8 pa2, bf16x8 pa3) {
    s16x4 A[8], B[8];
    pv_rd<0>(A, vb); asm volatile("s_waitcnt lgkmcnt(0)" ::: "memory"); SBAR();
    pv_rd<1>(B, vb); SBAR(); pv_mm(o[0], A, pa0, pa1, pa2, pa3); asm volatile("s_waitcnt lgkmcnt(0)" ::: "memory"); SBAR();
    pv_rd<2>(A, vb); SBAR(); pv_mm(o[1], B, pa0, pa1, pa2, pa3); asm volatile("s_waitcnt lgkmcnt(0)" ::: "memory"); SBAR();
    pv_rd<3>(B, vb); SBAR(); pv_mm(o[2], A, pa0, pa1, pa2, pa3); asm volatile("s_waitcnt lgkmcnt(0)" ::: "memory"); SBAR();
    pv_mm(o[3], B, pa0, pa1, pa2, pa3);
}
template <int VAR> __device__ __forceinline__ void pv_d0(f32x16* o, int vb, bf16x8 pa0, bf16x8 pa1, bf16x8 pa2, bf16x8 pa3) {
    if constexpr (VAR == 6) { pv_pipe(o, vb, pa0, pa1, pa2, pa3); return; }
    if constexpr (VAR == 3) { o[0][0] += __builtin_bit_cast(float, (int)pa0[0] << 16) + __builtin_bit_cast(float, (int)pa3[7] << 16) + __builtin_bit_cast(float, (int)pa1[0] << 16) + __builtin_bit_cast(float, (int)pa2[0] << 16); return; }
    pv_one<0>(o[0], vb, pa0, pa1, pa2, pa3); pv_one<1>(o[1], vb, pa0, pa1, pa2, pa3); pv_one<2>(o[2], vb, pa0, pa1, pa2, pa3); pv_one<3>(o[3], vb, pa0, pa1, pa2, pa3);
}
template <int VAR> __device__ __forceinline__ void body(const bf16_t* __restrict__ Qb, const bf16_t* __restrict__ Kh, const bf16_t* __restrict__ Vh, int seq, char* lds, f32x16 (&o)[4]) {
    const int tid = threadIdx.x, wid = tid >> 6, lane = tid & 63, r32 = lane & 31, hi = lane >> 5;
    char* V_lds = lds; char* K_lds = lds + 2 * SHM_V;
    float* ws = (float*)(lds + 2 * SHM_V + 2 * SHM_K) + wid * 64; float* li_l = ws; float* al_l = ws + 32;
    float m_reg = -1e30f, l_reg = 0; bf16x8 qr[4];
#pragma unroll
    for (int d = 0; d < 4; ++d) o[d] = f32x16{};
    const bf16_t* Qw = Qb + (size_t)(wid * QBLK + r32) * 64 + hi * 8;
#pragma unroll
    for (int d0 = 0; d0 < 4; ++d0) qr[d0] = *reinterpret_cast<const bf16x8*>(Qw + d0 * 16);
    const int sr = tid >> 4, sc = (tid & 15) * 8, vst0 = v_st(sr, sc), vst1 = v_st(32 + sr, sc);
    const int kr = tid >> 3, kc = (tid & 7) * 8, kst = KSWZ64(kr, kc * 2);
    const int vb0 = (int)(uintptr_t)V_lds + v_rd_base(lane);
    struct { bf16x8 vs0, vs1, ks0; } sr_[2];
#define SLOAD(i, k0) do { sr_[i].vs0 = *reinterpret_cast<const bf16x8*>(&Vh[(size_t)((k0) + sr) * 128 + sc]); sr_[i].vs1 = *reinterpret_cast<const bf16x8*>(&Vh[(size_t)((k0) + 32 + sr) * 128 + sc]); \
    sr_[i].ks0 = *reinterpret_cast<const bf16x8*>(&Kh[(size_t)((k0) + kr) * 64 + kc]); } while (0)
#define SWRITE(b, i) do { *(bf16x8*)(V_lds + (b) * SHM_V + vst0) = sr_[i].vs0; *(bf16x8*)(V_lds + (b) * SHM_V + vst1) = sr_[i].vs1; *(bf16x8*)(K_lds + (b) * SHM_K + kst) = sr_[i].ks0; } while (0)
#define SWAIT() asm volatile("s_waitcnt vmcnt(3)" ::: "memory")
#define RESC(a) do { if (__any((a) < 1.f)) { if (hi == 0) al_l[r32] = (a); asm volatile("s_waitcnt lgkmcnt(0)" ::: "memory"); \
    _Pragma("unroll") for (int d = 0; d < 4; ++d) _Pragma("unroll") for (int r = 0; r < 16; ++r) o[d][r] *= al_l[crow(r, hi)]; } } while (0)
    f32x16 pA0, pA1, pB0, pB1; float mnA, mnB, alA, alB; bf16x8 pa0, pa1, pa2, pa3; const int NT = seq / KVBLK;
    constexpr int SE = 0, SO = 1;
    SLOAD(SE, 0); asm volatile("s_waitcnt vmcnt(0)" ::: "memory"); SWRITE(0, SE); __syncthreads();
    qkt<VAR>(pA0, pA1, K_lds, qr, r32, hi); partialSM<VAR>(pA0, pA1, m_reg, mnA, alA);
    SLOAD(SO, KVBLK); if (2 < NT) SLOAD(SE, 2 * KVBLK);
    SWAIT(); SWRITE(1, SO); __syncthreads();
    for (int j = 1; j + 1 < NT; j += 2) {
        SBAR(); qkt<VAR>(pB0, pB1, K_lds + SHM_K, qr, r32, hi);
        finishSM<VAR>(pA0, pA1, alA, l_reg, pa0, pa1, pa2, pa3); SBAR();
        SLOAD(SO, (j + 2) * KVBLK); SBAR();
        pv_d0<VAR>(o, vb0, pa0, pa1, pa2, pa3); partialSM<VAR>(pB0, pB1, m_reg, mnB, alB);
        __syncthreads(); SWAIT(); SWRITE(0, SE);
        RESC(alB); if constexpr (VAR != 5) __syncthreads();
        SBAR(); qkt<VAR>(pA0, pA1, K_lds, qr, r32, hi);
        finishSM<VAR>(pB0, pB1, alB, l_reg, pa0, pa1, pa2, pa3); SBAR();
        if (j + 3 < NT) SLOAD(SE, (j + 3) * KVBLK); SBAR();
        pv_d0<VAR>(o, vb0 + SHM_V, pa0, pa1, pa2, pa3); partialSM<VAR>(pA0, pA1, m_reg, mnA, alA);
        __syncthreads(); SWAIT(); SWRITE(1, SO);
        RESC(alA); if constexpr (VAR != 5) __syncthreads();
    }
    SBAR(); qkt<VAR>(pB0, pB1, K_lds + SHM_K, qr, r32, hi);
    finishSM<VAR>(pA0, pA1, alA, l_reg, pa0, pa1, pa2, pa3); SBAR();
    pv_d0<VAR>(o, vb0, pa0, pa1, pa2, pa3); partialSM<VAR>(pB0, pB1, m_reg, mnB, alB);
    __syncthreads(); RESC(alB);
    finishSM<VAR>(pB0, pB1, alB, l_reg, pa0, pa1, pa2, pa3); SBAR();
    pv_d0<VAR>(o, vb0 + SHM_V, pa0, pa1, pa2, pa3);
    if (hi == 0) li_l[r32] = l_reg; asm volatile("s_waitcnt lgkmcnt(0)" ::: "memory");
#pragma unroll
    for (int r = 0; r < 16; ++r) { const float rl = __builtin_amdgcn_rcpf(li_l[crow(r, hi)]);
#pragma unroll
        for (int d = 0; d < 4; ++d) o[d][r] *= rl; }
    asm volatile("s_waitcnt vmcnt(0) lgkmcnt(0)" ::: "memory"); __syncthreads();
#undef SLOAD
#undef SWRITE
#undef SWAIT
#undef RESC
}
}

namespace dattn8 {
constexpr int NW = 8, QBLK = 32, KVBLK = 64;
constexpr float THR2 = 3.f * 1.4426950408889634f;
constexpr int SHM_V = 128 * 64, SHM_K = KVBLK * 64;
constexpr int NRING = 3;
constexpr int LDS_BYTES = NRING * SHM_V + NRING * SHM_K + NW * 64 * 4;
template <bool FIRST> __device__ __forceinline__ void partialSM(f32x16& p0, f32x16& p1, float& M, float& alpha, f32x16& zc) {
    float pmax = p0[0];
#pragma unroll
    for (int r = 1; r < 16; ++r) pmax = fmaxf(pmax, p0[r]);
#pragma unroll
    for (int r = 0; r < 16; ++r) pmax = fmaxf(pmax, p1[r]);
    { auto rr = __builtin_amdgcn_permlane32_swap(__float_as_uint(pmax), __float_as_uint(pmax), false, false); pmax = fmaxf(__uint_as_float(rr[0]), __uint_as_float(rr[1])); }
    alpha = 1.f;
    if (FIRST || !__builtin_expect(__all(pmax <= THR2 + 4.f), 1)) {
        const float delta = FIRST ? pmax - 4.f : fmaxf(pmax - 4.f, 0.f);
        M += delta; if (!FIRST) alpha = __builtin_amdgcn_exp2f(-delta);
#pragma unroll
        for (int r = 0; r < 16; ++r) { p0[r] -= delta; p1[r] -= delta; zc[r] = 4.f - M; }
    }
#pragma unroll
    for (int r = 0; r < 16; ++r) p0[r] = __builtin_amdgcn_exp2f(p0[r]);
}
__device__ __forceinline__ void finishSM(f32x16& p0, f32x16& p1, i32x8& pa) {
#pragma unroll
    for (int r = 0; r < 16; ++r) p1[r] = __builtin_amdgcn_exp2f(p1[r]);
#pragma unroll
    for (int g = 0; g < 4; ++g) {
        const unsigned d0 = cvt4_fp8n(p0[4 * g], p0[4 * g + 1], p0[4 * g + 2], p0[4 * g + 3]), d1 = cvt4_fp8n(p1[4 * g], p1[4 * g + 1], p1[4 * g + 2], p1[4 * g + 3]);
        auto rr = __builtin_amdgcn_permlane32_swap(d0, d1, false, false);
        pa[2 * g] = (int)rr[0]; pa[2 * g + 1] = (int)rr[1];
    }
}
__device__ __forceinline__ void pv(f32x16 (&o)[4], f32x16& lacc, const char* Vs, int va, const i32x8& pa, int mxs) {
#pragma unroll
    for (int d0 = 0; d0 < 4; ++d0) {
        const u32x4 x0 = *reinterpret_cast<const u32x4*>(Vs + d0 * 2048 + va), x1 = *reinterpret_cast<const u32x4*>(Vs + d0 * 2048 + (va ^ 16));
        const i32x8 bv = __builtin_bit_cast(i32x8, __builtin_shufflevector(x0, x1, 0, 1, 2, 3, 4, 5, 6, 7));
        asm("s_nop 1\n\tv_mfma_scale_f32_32x32x64_f8f6f4 %0, %1, %2, %0, %3, %3 op_sel_hi:[0,0,0]" : "+v"(o[d0]) : "v"(pa), "v"(bv), "v"(mxs));
    }
    const int one4 = 0x38383838;
    const i32x8 ones = {one4, one4, one4, one4, one4, one4, one4, one4};
    asm("s_nop 1\n\tv_mfma_scale_f32_32x32x64_f8f6f4 %0, %1, %2, %0, %3, %3 op_sel_hi:[0,0,0]" : "+v"(lacc) : "v"(pa), "v"(ones), "v"(mxs));
}
__device__ __forceinline__ void qkt8(f32x16& p0, f32x16& p1, const char* Ks, int ka, const i32x8& q8, const f32x16& z, int mxs) {
    const u32x4 x0 = *reinterpret_cast<const u32x4*>(Ks + ka), x1 = *reinterpret_cast<const u32x4*>(Ks + (ka ^ 16));
    const u32x4 y0 = *reinterpret_cast<const u32x4*>(Ks + 2048 + ka), y1 = *reinterpret_cast<const u32x4*>(Ks + 2048 + (ka ^ 16));
    const i32x8 k0 = __builtin_bit_cast(i32x8, __builtin_shufflevector(x0, x1, 0, 1, 2, 3, 4, 5, 6, 7)), k1 = __builtin_bit_cast(i32x8, __builtin_shufflevector(y0, y1, 0, 1, 2, 3, 4, 5, 6, 7));
    p0 = __builtin_amdgcn_mfma_scale_f32_32x32x64_f8f6f4(k0, q8, z, 0, 0, 0, mxs, 0, 0x7C7C7C7C);
    p1 = __builtin_amdgcn_mfma_scale_f32_32x32x64_f8f6f4(k1, q8, z, 0, 0, 0, mxs, 0, 0x7C7C7C7C);
}
template <int VAR = 0> __device__ __forceinline__ void body(const unsigned char* __restrict__ Qb8, const unsigned char* __restrict__ Kh8, const unsigned char* __restrict__ V8, int seq, char* lds, f32x16 (&o)[4]) {
    constexpr int V8LD = NKEY;
    const int tid = threadIdx.x, wid = tid >> 6, lane = tid & 63, r32 = lane & 31, hi = lane >> 5;
    char* V_lds = lds; char* K_lds = lds + NRING * SHM_V;
    float* ws = (float*)(lds + NRING * SHM_V + NRING * SHM_K) + wid * 64; float* al_l = ws;
    float M = 0.f; const int mxs = 0x7F7F7F7F; f32x16 lacc = f32x16{};
#pragma unroll
    for (int d = 0; d < 4; ++d) o[d] = f32x16{};
    i32x8 q8;
    { const unsigned char* qp = Qb8 + (size_t)(wid * QBLK + r32) * 64 + 32 * hi; const u32x4 x0 = *reinterpret_cast<const u32x4*>(qp), x1 = *reinterpret_cast<const u32x4*>(qp + 16);
      q8 = __builtin_bit_cast(i32x8, __builtin_shufflevector(x0, x1, 0, 1, 2, 3, 4, 5, 6, 7)); }
    const int vdv = tid >> 2, vch = tid & 3, vst = vdv * 64 + ((vch ^ ((vdv >> 2) & 3)) << 4);
    const int kr = (tid >> 2) & 63, kst = kr * 64 + ((vch ^ ((kr >> 2) & 3)) << 4);
    const int va = r32 * 64 + (((2 * hi) ^ ((r32 >> 2) & 3)) << 4);
    struct { u32x4 vs0, ks0; } sr_[2];
#define SLOAD(i, k0) do { sr_[i].vs0 = *reinterpret_cast<const u32x4*>(V8 + (size_t)vdv * V8LD + (k0) + vch * 16); sr_[i].ks0 = *reinterpret_cast<const u32x4*>(Kh8 + (size_t)((k0) + kr) * 64 + vch * 16); } while (0)
#define SWRITE(b, i) do { *(u32x4*)(V_lds + (b) * SHM_V + vst) = sr_[i].vs0; if (tid < 256) *(u32x4*)(K_lds + (b) * SHM_K + kst) = sr_[i].ks0; } while (0)
#define SWAIT() asm volatile("s_waitcnt vmcnt(2)" ::: "memory")
#define RESC(a) do { if (__any((a) < 1.f)) { if (hi == 0) al_l[r32] = (a); asm volatile("s_nop 7\n\ts_nop 7\n\ts_nop 7\n\ts_waitcnt lgkmcnt(0)" : "+v"(o[0]), "+v"(o[1]), "+v"(o[2]), "+v"(o[3]), "+v"(lacc) :: "memory"); \
    _Pragma("unroll") for (int r = 0; r < 16; ++r) { const float a_ = al_l[crow(r, hi)]; lacc[r] *= a_; _Pragma("unroll") for (int d = 0; d < 4; ++d) o[d][r] *= a_; } } } while (0)
    f32x16 pA0, pA1, pB0, pB1; float alA, alB; const int NT = seq / KVBLK;
    constexpr int SE = 0, SO = 1;
    SLOAD(SE, 0); asm volatile("s_waitcnt vmcnt(0)" ::: "memory"); SWRITE(0, SE); __syncthreads();
#define QK_(P0, P1, KS, NM) do { if constexpr (VAR == 4 || VAR == 5) { _Pragma("unroll") for (int r_ = 0; r_ < 16; ++r_) { P0[r_] = zc[r_] + (float)r_; P1[r_] = zc[r_]; } } else qkt8(P0, P1, KS, va, q8, zc, mxs); } while (0)
#define PSM_(F, P0, P1, AL) do { if constexpr (VAR == 5) { AL = 1.f; } else partialSM<F>(P0, P1, M, AL, zc); } while (0)
#define FSM_(P0, P1) do { if constexpr (VAR == 5) { pa[0] = (int)__float_as_uint(P0[0]); } else finishSM(P0, P1, pa); } while (0)
#define PV_(VS) do { if constexpr (VAR == 3 || VAR == 5) { o[0][0] += __uint_as_float((unsigned)pa[0]) + __uint_as_float((unsigned)pa[7]); } else pv(o, lacc, VS, va, pa, mxs); } while (0)
    i32x8 pa = {0, 0, 0, 0, 0, 0, 0, 0};
    f32x16 zc;
#pragma unroll
    for (int r = 0; r < 16; ++r) zc[r] = 4.f;
    QK_(pA0, pA1, K_lds, 4.f); PSM_(true, pA0, pA1, alA);
    SLOAD(SO, KVBLK); SLOAD(SE, ((2 < NT) ? 2 : NT - 1) * KVBLK);
    SWAIT(); SWRITE(1, SO); __syncthreads();
    int rk = 1, rv = 0, rw = 2;
#define STEP_(j, PC0, PC1, PP0, PP1, ALC, SW, SL) do { \
        SBAR(); QK_(PC0, PC1, K_lds + rk * SHM_K, 4.f - M); FSM_(PP0, PP1); SBAR(); \
        SLOAD(SL, (((j) + 2 < NT) ? (j) + 2 : NT - 1) * KVBLK); SBAR(); \
        PV_(V_lds + rv * SHM_V); PSM_(false, PC0, PC1, ALC); \
        SWAIT(); SWRITE(rw, SW); RESC(ALC); __syncthreads(); \
        rv = rk; rk = rw; rw = (rw == NRING - 1) ? 0 : rw + 1; } while (0)
    for (int j = 1; j + 1 < NT; j += 2) {
        STEP_(j, pB0, pB1, pA0, pA1, alB, SE, SO);
        STEP_(j + 1, pA0, pA1, pB0, pB1, alA, SO, SE);
    }
    SBAR(); QK_(pB0, pB1, K_lds + rk * SHM_K, 4.f - M);
    FSM_(pA0, pA1); SBAR();
    PV_(V_lds + rv * SHM_V); PSM_(false, pB0, pB1, alB);
    RESC(alB);
    FSM_(pB0, pB1); SBAR();
    PV_(V_lds + rk * SHM_V);
#undef STEP_
    asm volatile("s_nop 7\n\ts_nop 7\n\ts_nop 7" : "+v"(o[0]), "+v"(o[1]), "+v"(o[2]), "+v"(o[3]), "+v"(lacc) :: "memory");
#pragma unroll
    for (int r = 0; r < 16; ++r) { const float rl = __builtin_amdgcn_rcpf(lacc[r]);
#pragma unroll
        for (int d = 0; d < 4; ++d) o[d][r] *= rl; }
    asm volatile("s_waitcnt vmcnt(0) lgkmcnt(0)" ::: "memory"); __syncthreads();
#undef SLOAD
#undef SWRITE
#undef SWAIT
#undef RESC
#undef QK_
#undef PSM_
#undef FSM_
#undef PV_
}
}

#define XB_TMO      128
#define XB_XCNT(j)  (256  + 64 * (j))
#define XB_XSUB(j)  (1280 + 64 * (j))
#define XB_XGEN(j)  (2304 + 64 * (j))
#define XB_TOP      3328
#define XB_TOPGEN   3392
#define XCD_BAR_WORDS 3456
#define XB_SPIN_CAP (1u << 18)
__device__ __forceinline__ unsigned xb_ld(unsigned* p)              { return __hip_atomic_load(p, __ATOMIC_RELAXED, __HIP_MEMORY_SCOPE_AGENT); }
__device__ __forceinline__ unsigned xb_add(unsigned* p, unsigned v) { return __hip_atomic_fetch_add(p, v, __ATOMIC_RELAXED, __HIP_MEMORY_SCOPE_AGENT); }
__device__ __forceinline__ unsigned xb_xcc_id() { return (unsigned)__builtin_amdgcn_s_getreg((3 << 11) | 20) & 0xFu; }
#define XB_SPIN(cond, bar) do { unsigned _sp = 0; while (cond) { __builtin_amdgcn_s_sleep(1); \
    if ((++_sp & 255u) == 0u) { if (xb_ld(&(bar)[XB_TMO])) break; if (_sp > XB_SPIN_CAP) { atomicAdd(&(bar)[XB_TMO], 1u); break; } } } } while (0)
struct XcdBarrier { unsigned* bar; unsigned x; volatile LAS unsigned* st; };
__device__ __forceinline__ XcdBarrier xcd_barrier_post(unsigned* bar, volatile LAS unsigned* st) {
    XcdBarrier b; b.bar = bar; b.x = xb_xcc_id(); b.st = st;
    if (threadIdx.x == 0) (void)xb_add(&bar[XB_XCNT(b.x)], 1u);
    return b;
}
__device__ __forceinline__ void xcd_barrier_complete(unsigned* bar, unsigned x, unsigned& nloc, unsigned& nx) {
    const unsigned G = gridDim.x * gridDim.y * gridDim.z;
    unsigned sum, cnt, mine, sp = 0u;
    for (;;) {
        sum = 0u; cnt = 0u; mine = 0u;
#pragma unroll
        for (unsigned j = 0; j < 16; ++j) { const unsigned c = xb_ld(&bar[XB_XCNT(j)]); sum += c; cnt += (c > 0u) ? 1u : 0u; mine = (j == x) ? c : mine; }
        if (sum == G) break;
        __builtin_amdgcn_s_sleep(1);
        if ((++sp & 255u) == 0u) { if (xb_ld(&bar[XB_TMO])) break; if (sp > XB_SPIN_CAP) { atomicAdd(&bar[XB_TMO], 1u); break; } }
    }
    nloc = mine > 0u ? mine : 1u; nx = cnt > 0u ? cnt : 1u;
}
__device__ __forceinline__ void xcd_barrier(const XcdBarrier& b) {
    asm volatile("s_waitcnt vmcnt(0)" ::: "memory");
    __syncthreads();
    if (threadIdx.x == 0) {
        unsigned* bar = b.bar;
        __builtin_amdgcn_s_waitcnt(0);
        unsigned nloc = b.st[0], nx = b.st[1];
        if (nloc == 0u) { xcd_barrier_complete(bar, b.x, nloc, nx); b.st[0] = nloc; b.st[1] = nx; }
        const unsigned mygen = b.st[2]; b.st[2] = mygen + 1u;
        const unsigned old = xb_add(&bar[XB_XSUB(b.x)], 1u);
        if (old + 1u == (mygen + 1u) * nloc) {
            __builtin_amdgcn_fence(__ATOMIC_RELEASE, "agent");
            asm volatile("s_waitcnt vmcnt(0)" ::: "memory");
            const unsigned og = xb_add(&bar[XB_TOP], 1u);
            if (og + 1u == (mygen + 1u) * nx) xb_add(&bar[XB_TOPGEN], 1u);
        }
        XB_SPIN(xb_ld(&bar[XB_TOPGEN]) <= mygen, bar);
        __builtin_amdgcn_fence(__ATOMIC_ACQUIRE, "agent");
        asm volatile("s_waitcnt vmcnt(0)" ::: "memory");
    }
    __syncthreads();
}

constexpr int RING_BYTES = 131072;
constexpr int MISC_OFF = RING_BYTES + 320;
constexpr int LDS_BYTES = 132096;
constexpr int NWAVES = 8;

__device__ __forceinline__ void transpose_item(const float* __restrict__ W, int K, int N, bf16_t* WT, int kb, int nb, int dst_row0, LAS float* scr, int lane) {
    const int k0 = 64 * kb, n0 = 32 * nb;
    {
        f32x4 t[8];
#pragma unroll
        for (int i = 0; i < 8; ++i) t[i] = *(const f32x4*)(W + (size_t)(k0 + 8 * i + (lane >> 3)) * N + n0 + 4 * (lane & 7));
#pragma unroll
        for (int i = 0; i < 8; ++i) { LAS float* d = scr + (8 * i + (lane >> 3)) * 33 + 4 * (lane & 7); d[0] = t[i].x; d[1] = t[i].y; d[2] = t[i].z; d[3] = t[i].w; }
    }
    LDS_WAIT(); asm volatile("" ::: "memory");
    const int c = lane & 7;
#pragma unroll
    for (int j = 0; j < 4; ++j) { const int n = (lane >> 3) + 8 * j; const LAS float* s = scr + (8 * c) * 33 + n;
        u32x4 o; o.x = cvtpk(s[0 * 33], s[1 * 33]); o.y = cvtpk(s[2 * 33], s[3 * 33]); o.z = cvtpk(s[4 * 33], s[5 * 33]); o.w = cvtpk(s[6 * 33], s[7 * 33]);
        *(u32x4*)(WT + (size_t)(dst_row0 + n) * K + k0 + 8 * c) = o; }
    LDS_WAIT(); asm volatile("" ::: "memory");
}
__device__ __forceinline__ void transpose_item_fp8(const float* __restrict__ W, int K, int N, unsigned char* WT8, int kb, int nb, int dst_row0, float wscale, LAS float* scr, int lane) {
    const int k0 = 64 * kb, n0 = 32 * nb;
    {
        f32x4 t[8];
#pragma unroll
        for (int i = 0; i < 8; ++i) t[i] = *(const f32x4*)(W + (size_t)(k0 + 8 * i + (lane >> 3)) * N + n0 + 4 * (lane & 7));
#pragma unroll
        for (int i = 0; i < 8; ++i) { LAS float* d = scr + (8 * i + (lane >> 3)) * 33 + 4 * (lane & 7); d[0] = t[i].x; d[1] = t[i].y; d[2] = t[i].z; d[3] = t[i].w; }
    }
    LDS_WAIT(); asm volatile("" ::: "memory");
    const int c = lane & 7;
#pragma unroll
    for (int j = 0; j < 4; ++j) { const int n = (lane >> 3) + 8 * j; const LAS float* sp = scr + (8 * c) * 33 + n;
        u32x2 o; o.x = cvt4_fp8s(sp[0 * 33] * wscale, sp[1 * 33] * wscale, sp[2 * 33] * wscale, sp[3 * 33] * wscale); o.y = cvt4_fp8s(sp[4 * 33] * wscale, sp[5 * 33] * wscale, sp[6 * 33] * wscale, sp[7 * 33] * wscale);
        *(u32x2*)(WT8 + (size_t)(dst_row0 + n) * K + k0 + 8 * c) = o; }
    LDS_WAIT(); asm volatile("" ::: "memory");
}
__device__ __forceinline__ void load_row16(const float* src, int lane, f32x4 (&v)[4]) {
#pragma unroll
    for (int j = 0; j < 4; ++j) v[j] = *(const f32x4*)(src + 4 * lane + 256 * j);
}
__device__ __forceinline__ void load_row16_bf(const bf16_t* src, int lane, f32x4 (&v)[4]) {
#pragma unroll
    for (int j = 0; j < 4; ++j) { const u32x2 w = *(const u32x2*)(src + 4 * lane + 256 * j); v[j] = (f32x4){bflo(w.x), bfhi(w.x), bflo(w.y), bfhi(w.y)}; }
}
__device__ __forceinline__ float row_rstd(const f32x4 (&v)[4]) {
    float s = 0.f;
#pragma unroll
    for (int j = 0; j < 4; ++j) s += (v[j].x * v[j].x + v[j].y * v[j].y) + (v[j].z * v[j].z + v[j].w * v[j].w);
    return rsqrtf(wave_sum(s) * (1.f / D) + EPS);
}
__device__ __forceinline__ void modulate_store(f32x4 (&v)[4], float rstd, const float* g, const float* sh, const float* sc, bf16_t* dst, int lane) {
#pragma unroll
    for (int j = 0; j < 4; ++j) { const int c = 4 * lane + 256 * j;
        const f32x4 gg = *(const f32x4*)(g + c), s1 = *(const f32x4*)(sc + c), s0 = *(const f32x4*)(sh + c);
        v[j] = v[j] * rstd * gg * (1.f + s1) + s0;
        *(u32x2*)(dst + c) = (u32x2){cvtpk(v[j].x, v[j].y), cvtpk(v[j].z, v[j].w)}; }
}

__device__ __forceinline__ void modulate_store2(f32x4 (&v)[4], float rstd, const float* g, const float* sh, const float* sc, bf16_t* dst, unsigned char* dst8, int lane) {
#pragma unroll
    for (int j = 0; j < 4; ++j) { const int c = 4 * lane + 256 * j;
        const f32x4 gg = *(const f32x4*)(g + c), s1 = *(const f32x4*)(sc + c), s0 = *(const f32x4*)(sh + c);
        v[j] = v[j] * rstd * gg * (1.f + s1) + s0;
        *(u32x2*)(dst + c) = (u32x2){cvtpk(v[j].x, v[j].y), cvtpk(v[j].z, v[j].w)};
        *(unsigned*)(dst8 + c) = cvt4_fp8s(v[j].x, v[j].y, v[j].z, v[j].w); }
}
__device__ __forceinline__ void small_tile(const bf16_t* __restrict__ A, int lda, const bf16_t* __restrict__ Bt, int ldb, int wr, int wc, int r32, int hi, f32x16& acc0, f32x16& acc1) {
    acc0 = f32x16{}; acc1 = f32x16{};
    const bf16_t* ap = A + (size_t)(32 * wr + r32) * lda + 8 * hi;
    const bf16_t* b0p = Bt + (size_t)(64 * wc + r32) * ldb + 8 * hi;
    const bf16_t* b1p = b0p + (size_t)32 * ldb;
#pragma unroll
    for (int s = 0; s < 8; ++s) {
        const bf16x8 a = *reinterpret_cast<const bf16x8*>(ap + 16 * s), b0 = *reinterpret_cast<const bf16x8*>(b0p + 16 * s), b1 = *reinterpret_cast<const bf16x8*>(b1p + 16 * s);
        acc0 = __builtin_amdgcn_mfma_f32_32x32x16_bf16(a, b0, acc0, 0, 0, 0);
        acc1 = __builtin_amdgcn_mfma_f32_32x32x16_bf16(a, b1, acc1, 0, 0, 0);
    }
}

__device__ __forceinline__ void small_tile_ln(const bf16_t* __restrict__ A, int lda, const bf16_t* __restrict__ Bt, int ldb, int wr, int wc, int r32, int hi, const LAS float* RS, const LAS float* RM, f32x16& acc0, f32x16& acc1, float& c0) {
    acc0 = f32x16{}; acc1 = f32x16{}; c0 = 0.f;
    const bf16_t* ap = A + (size_t)(32 * wr + r32) * lda + 8 * hi;
    const bf16_t* b0p = Bt + (size_t)(64 * wc + r32) * ldb + 8 * hi;
    const bf16_t* b1p = b0p + (size_t)32 * ldb;
#pragma unroll
    for (int s = 0; s < 8; ++s) {
        const u32x4 aw = *reinterpret_cast<const u32x4*>(ap + 16 * s);
        const bf16x8 b0 = *reinterpret_cast<const bf16x8*>(b0p + 16 * s), b1 = *reinterpret_cast<const bf16x8*>(b1p + 16 * s);
        const f32x4 r0 = *(const LAS f32x4*)(RS + 16 * s + 8 * hi), r1 = *(const LAS f32x4*)(RS + 16 * s + 8 * hi + 4);
        const f32x4 m0 = *(const LAS f32x4*)(RM + 16 * s + 8 * hi), m1 = *(const LAS f32x4*)(RM + 16 * s + 8 * hi + 4);
        const f32x4 a0 = (f32x4){bflo(aw.x), bfhi(aw.x), bflo(aw.y), bfhi(aw.y)}, a1 = (f32x4){bflo(aw.z), bfhi(aw.z), bflo(aw.w), bfhi(aw.w)};
        const f32x4 cm = a0 * m0 + a1 * m1; c0 += (cm.x + cm.y) + (cm.z + cm.w);
        const f32x4 s0 = a0 * r0, s1 = a1 * r1;
        const bf16x8 as = __builtin_bit_cast(bf16x8, (u32x4){cvtpk(s0.x, s0.y), cvtpk(s0.z, s0.w), cvtpk(s1.x, s1.y), cvtpk(s1.z, s1.w)});
        acc0 = __builtin_amdgcn_mfma_f32_32x32x16_bf16(as, b0, acc0, 0, 0, 0);
        acc1 = __builtin_amdgcn_mfma_f32_32x32x16_bf16(as, b1, acc1, 0, 0, 0);
    }
}

__device__ __forceinline__ void na_loadk(const bf16_t* __restrict__ NK, size_t kb, int h, int r32, int hi, bf16x8 (&kf)[8]) {
    const bf16_t* kp = NK + (kb + r32) * 512 + h * 64 + hi * 8;
#pragma unroll
    for (int d0 = 0; d0 < 4; ++d0) { kf[2 * d0] = *reinterpret_cast<const bf16x8*>(kp + d0 * 16); kf[2 * d0 + 1] = *reinterpret_cast<const bf16x8*>(kp + 32 * 512 + d0 * 16); }
}
__device__ __forceinline__ void na_loadv(const bf16_t* __restrict__ NVT, size_t kb, int h, int r32, int hi, bf16x8 (&vf)[8]) {
#pragma unroll
    for (int d0 = 0; d0 < 2; ++d0)
#pragma unroll
        for (int ks = 0; ks < 4; ++ks) vf[d0 * 4 + ks] = *reinterpret_cast<const bf16x8*>(NVT + (size_t)(h * 64 + 32 * d0 + r32) * MROWS + kb + 16 * ks + 8 * hi);
}
__device__ __forceinline__ void na_qk(const bf16x8 (&kf)[8], const bf16x8 (&qr)[4], f32x16& p0, f32x16& p1) {
    p0 = f32x16{}; p1 = f32x16{};
#pragma unroll
    for (int d0 = 0; d0 < 4; ++d0) {
        p0 = __builtin_amdgcn_mfma_f32_32x32x16_bf16(kf[2 * d0], qr[d0], p0, 0, 0, 0);
        p1 = __builtin_amdgcn_mfma_f32_32x32x16_bf16(kf[2 * d0 + 1], qr[d0], p1, 0, 0, 0);
    }
}
__device__ __forceinline__ void na_smpv(f32x16& p0, f32x16& p1, const bf16x8 (&vf)[8], int r32, int hi, const LAS float* lb, unsigned mlo, unsigned mhi,
                                        float& m_reg, float& l_reg, f32x16 (&o)[2], LAS float* al_l) {
    float pmax = -INFINITY;
    if (lb) {
#pragma unroll
        for (int r = 0; r < 16; ++r) { const int c = (r & 3) + 8 * (r >> 2);
            const float b0 = lb[c], b1 = lb[32 + c];
            p0[r] = ((mlo >> c) & 1u) ? fmaf(p0[r], 0.125f, b0) : -INFINITY; p1[r] = ((mhi >> c) & 1u) ? fmaf(p1[r], 0.125f, b1) : -INFINITY;
            pmax = fmaxf(pmax, fmaxf(p0[r], p1[r])); }
    } else {
#pragma unroll
        for (int r = 0; r < 16; ++r) { p0[r] *= 0.125f; p1[r] *= 0.125f; pmax = fmaxf(pmax, fmaxf(p0[r], p1[r])); }
    }
    { auto rr = __builtin_amdgcn_permlane32_swap(__float_as_uint(pmax), __float_as_uint(pmax), false, false); pmax = fmaxf(__uint_as_float(rr[0]), __uint_as_float(rr[1])); }
    const float mn = fmaxf(m_reg, pmax); const float alpha = __expf(m_reg - mn); m_reg = mn;
    float ps = 0.f;
#pragma unroll
    for (int r = 0; r < 16; ++r) { p0[r] = __expf(p0[r] - mn); p1[r] = __expf(p1[r] - mn); ps += p0[r] + p1[r]; }
    { auto rr = __builtin_amdgcn_permlane32_swap(__float_as_uint(ps), __float_as_uint(ps), false, false); ps = __uint_as_float(rr[0]) + __uint_as_float(rr[1]); }
    l_reg = l_reg * alpha + ps;
    bf16x8 pa0, pa1, pa2, pa3;
    PK4(p0, 0, pa0); PK4(p0, 8, pa1); PK4(p1, 0, pa2); PK4(p1, 8, pa3);
    if (__any(alpha < 1.f)) {
        if (hi == 0) al_l[r32] = alpha;
        LDS_WAIT();
#pragma unroll
        for (int r = 0; r < 16; ++r) { const float a = al_l[crow(r, hi)]; o[0][r] *= a; o[1][r] *= a; }
        LDS_WAIT();
    }
#pragma unroll
    for (int d0 = 0; d0 < 2; ++d0) {
        o[d0] = __builtin_amdgcn_mfma_f32_32x32x16_bf16(pa0, vf[d0 * 4 + 0], o[d0], 0, 0, 0);
        o[d0] = __builtin_amdgcn_mfma_f32_32x32x16_bf16(pa1, vf[d0 * 4 + 1], o[d0], 0, 0, 0);
        o[d0] = __builtin_amdgcn_mfma_f32_32x32x16_bf16(pa2, vf[d0 * 4 + 2], o[d0], 0, 0, 0);
        o[d0] = __builtin_amdgcn_mfma_f32_32x32x16_bf16(pa3, vf[d0 * 4 + 3], o[d0], 0, 0, 0);
    }
}

__device__ __forceinline__ void na_smpv_lds(f32x16& p0, f32x16& p1, int vb, int r32, int hi, const LAS float* lb, unsigned mlo, unsigned mhi,
                                            float& m_reg, float& l_reg, f32x16 (&o)[2], LAS float* al_l) {
    float pmax = -INFINITY;
    if (lb) {
#pragma unroll
        for (int r = 0; r < 16; ++r) { const int c = (r & 3) + 8 * (r >> 2);
            const float b0 = lb[c], b1 = lb[32 + c];
            p0[r] = ((mlo >> c) & 1u) ? fmaf(p0[r], 0.125f, b0) : -INFINITY; p1[r] = ((mhi >> c) & 1u) ? fmaf(p1[r], 0.125f, b1) : -INFINITY;
            pmax = fmaxf(pmax, fmaxf(p0[r], p1[r])); }
    } else {
#pragma unroll
        for (int r = 0; r < 16; ++r) { p0[r] *= 0.125f; p1[r] *= 0.125f; pmax = fmaxf(pmax, fmaxf(p0[r], p1[r])); }
    }
    { auto rr = __builtin_amdgcn_permlane32_swap(__float_as_uint(pmax), __float_as_uint(pmax), false, false); pmax = fmaxf(__uint_as_float(rr[0]), __uint_as_float(rr[1])); }
    const float mn = fmaxf(m_reg, pmax); const float alpha = __expf(m_reg - mn); m_reg = mn;
    float ps = 0.f;
#pragma unroll
    for (int r = 0; r < 16; ++r) { p0[r] = __expf(p0[r] - mn); p1[r] = __expf(p1[r] - mn); ps += p0[r] + p1[r]; }
    { auto rr = __builtin_amdgcn_permlane32_swap(__float_as_uint(ps), __float_as_uint(ps), false, false); ps = __uint_as_float(rr[0]) + __uint_as_float(rr[1]); }
    l_reg = l_reg * alpha + ps;
    bf16x8 pa0, pa1, pa2, pa3;
    PK4(p0, 0, pa0); PK4(p0, 8, pa1); PK4(p1, 0, pa2); PK4(p1, 8, pa3);
    if (__any(alpha < 1.f)) {
        if (hi == 0) al_l[r32] = alpha;
        LDS_WAIT();
#pragma unroll
        for (int r = 0; r < 16; ++r) { const float a = al_l[crow(r, hi)]; o[0][r] *= a; o[1][r] *= a; }
        LDS_WAIT();
    }
    dattn::pv_one<0>(o[0], vb, pa0, pa1, pa2, pa3); dattn::pv_one<1>(o[1], vb, pa0, pa1, pa2, pa3);
}

__device__ __forceinline__ void na_smpv_fp8(f32x16& p0, f32x16& p1, const char* Vs, int va, int r32, int hi, const LAS float* lb, unsigned mlo, unsigned mhi,
                                            float& M, f32x16& lacc, f32x16 (&o)[2], LAS float* al_l, int mxs) {
    float pmax = -INFINITY;
    if (lb) {
#pragma unroll
        for (int r = 0; r < 16; ++r) { const int c = (r & 3) + 8 * (r >> 2);
            const float b0 = lb[c], b1 = lb[32 + c];
            p0[r] = ((mlo >> c) & 1u) ? p0[r] + b0 : -INFINITY; p1[r] = ((mhi >> c) & 1u) ? p1[r] + b1 : -INFINITY;
            pmax = fmaxf(pmax, fmaxf(p0[r], p1[r])); }
    } else {
#pragma unroll
        for (int r = 0; r < 16; ++r) pmax = fmaxf(pmax, fmaxf(p0[r], p1[r]));
    }
    { auto rr = __builtin_amdgcn_permlane32_swap(__float_as_uint(pmax), __float_as_uint(pmax), false, false); pmax = fmaxf(__uint_as_float(rr[0]), __uint_as_float(rr[1])); }
    const float mn = fmaxf(M, pmax); const float alpha = __builtin_amdgcn_exp2f(M - mn); M = mn; const float sh = 4.f - mn;
#pragma unroll
    for (int r = 0; r < 16; ++r) { p0[r] = __builtin_amdgcn_exp2f(p0[r] + sh); p1[r] = __builtin_amdgcn_exp2f(p1[r] + sh); }
    i32x8 pa;
#pragma unroll
    for (int g = 0; g < 4; ++g) {
        const unsigned d0 = cvt4_fp8n(p0[4 * g], p0[4 * g + 1], p0[4 * g + 2], p0[4 * g + 3]), d1 = cvt4_fp8n(p1[4 * g], p1[4 * g + 1], p1[4 * g + 2], p1[4 * g + 3]);
        auto rr = __builtin_amdgcn_permlane32_swap(d0, d1, false, false);
        pa[2 * g] = (int)rr[0]; pa[2 * g + 1] = (int)rr[1];
    }
    if (__any(alpha < 1.f)) {
        if (hi == 0) al_l[r32] = alpha;
        asm volatile("s_nop 7\n\ts_nop 7\n\ts_nop 7\n\ts_waitcnt lgkmcnt(0)" : "+v"(o[0]), "+v"(o[1]), "+v"(lacc) :: "memory");
#pragma unroll
        for (int r = 0; r < 16; ++r) { const float a = al_l[crow(r, hi)]; o[0][r] *= a; o[1][r] *= a; lacc[r] *= a; }
        LDS_WAIT();
    }
#pragma unroll
    for (int d0 = 0; d0 < 2; ++d0) {
        const u32x4 x0 = *reinterpret_cast<const u32x4*>(Vs + d0 * 2048 + va), x1 = *reinterpret_cast<const u32x4*>(Vs + d0 * 2048 + (va ^ 16));
        const i32x8 bv = __builtin_bit_cast(i32x8, __builtin_shufflevector(x0, x1, 0, 1, 2, 3, 4, 5, 6, 7));
        asm("s_nop 1\n\tv_mfma_scale_f32_32x32x64_f8f6f4 %0, %1, %2, %0, %3, %3 op_sel_hi:[0,0,0]" : "+v"(o[d0]) : "v"(pa), "v"(bv), "v"(mxs));
    }
    const int one4 = 0x38383838; const i32x8 ones = {one4, one4, one4, one4, one4, one4, one4, one4};
    asm("s_nop 1\n\tv_mfma_scale_f32_32x32x64_f8f6f4 %0, %1, %2, %0, %3, %3 op_sel_hi:[0,0,0]" : "+v"(lacc) : "v"(pa), "v"(ones), "v"(mxs));
}

__device__ __forceinline__ void topk_list(LAS unsigned* sh, const float* __restrict__ aff, int N, int Ksel, int rowbase, int e, int slotbase, int* IDXROW, float* GATE, int* SEL) {
    LAS unsigned* hist = sh; LAS unsigned* wtot = sh + 256; LAS unsigned* ctl = sh + 272;
    const int tid = threadIdx.x, lane = tid & 63, wid = tid >> 6, base = tid * 16;
    unsigned k[16];
    if (base < N) {
#pragma unroll
        for (int j = 0; j < 4; ++j) { const f32x4 v = *(const f32x4*)(aff + base + 4 * j); k[4 * j] = __float_as_uint(v.x); k[4 * j + 1] = __float_as_uint(v.y); k[4 * j + 2] = __float_as_uint(v.z); k[4 * j + 3] = __float_as_uint(v.w); }
    } else {
#pragma unroll
        for (int j = 0; j < 16; ++j) k[j] = 0u;
    }
    if (tid == 0) { ctl[0] = 0u; ctl[1] = (unsigned)Ksel; }
    for (int pass = 0; pass < 4; ++pass) {
        const int shift = 24 - 8 * pass;
        if (tid < 256) hist[tid] = 0u;
        __syncthreads();
        const unsigned prefix = ctl[0], rem = ctl[1];
        if (base < N) {
#pragma unroll
            for (int j = 0; j < 16; ++j) { const bool match = (pass == 0) ? true : ((k[j] >> ((shift + 8) & 31)) == prefix); if (match) __hip_atomic_fetch_add(&hist[(k[j] >> shift) & 255u], 1u, __ATOMIC_RELAXED, __HIP_MEMORY_SCOPE_WORKGROUP); }
        }
        __syncthreads();
        if (wid == 0) {
            const unsigned c0 = hist[4 * lane], c1 = hist[4 * lane + 1], c2 = hist[4 * lane + 2], c3 = hist[4 * lane + 3];
            const unsigned s = c0 + c1 + c2 + c3; unsigned S = s;
#pragma unroll
            for (int off = 1; off < 64; off <<= 1) { const unsigned t = __shfl_down(S, off); if (lane + off < 64) S += t; }
            const unsigned above = S - s;
            if (above < rem && rem <= S) {
                unsigned a = above; int digit;
                if (a + c3 >= rem) digit = 3; else { a += c3; if (a + c2 >= rem) digit = 2; else { a += c2; if (a + c1 >= rem) digit = 1; else { a += c1; digit = 0; } } }
                ctl[0] = (prefix << 8) | (unsigned)(4 * lane + digit); ctl[1] = rem - a;
            }
        }
        __syncthreads();
    }
    const unsigned T = ctl[0], rem = ctl[1];
    unsigned g = 0, q = 0;
    if (base < N) {
#pragma unroll
        for (int j = 0; j < 16; ++j) { g += (k[j] > T) ? 1u : 0u; q += (k[j] == T) ? 1u : 0u; }
    }
    const unsigned packed = g | (q << 16); unsigned incl = packed;
#pragma unroll
    for (int off = 1; off < 64; off <<= 1) { const unsigned t = __shfl_up(incl, off); if (lane >= off) incl += t; }
    if (lane == 63) wtot[wid] = incl;
    __syncthreads();
    unsigned woff = 0;
    for (int w = 0; w < wid; ++w) woff += wtot[w];
    const unsigned excl = incl - packed + woff;
    unsigned Gb = excl & 0xffffu, Eb = excl >> 16;
    if (base < N) {
        int sel[16];
#pragma unroll
        for (int j = 0; j < 16; ++j) {
            const bool gt = k[j] > T, eq = k[j] == T; const bool selq = gt || (eq && Eb < rem);
            const unsigned slot = Gb + (Eb < rem ? Eb : rem);
            const int row = rowbase + base + j;
            sel[j] = selq ? (int)(slotbase + slot) : -1;
            if (selq) { IDXROW[e * ESLOT + slotbase + slot] = row; GATE[e * ESLOT + slotbase + slot] = __uint_as_float(k[j]); }
            Gb += gt ? 1u : 0u; Eb += eq ? 1u : 0u;
        }
        int* sp = SEL + (size_t)e * MROWS + rowbase + base;
#pragma unroll
        for (int j = 0; j < 4; ++j) *(i32x4_t*)(sp + 4 * j) = (i32x4_t){sel[4 * j], sel[4 * j + 1], sel[4 * j + 2], sel[4 * j + 3]};
    }
    __syncthreads();
}

#define ws (args.ws)
#define ctl ((unsigned*)(ws + WS_CTL))
#define SMALL ((float*)(ws + WS_SMALL))
#define MOD (SMALL + SM_MOD)
#define ROPE (SMALL + SM_ROPE)
#define LAM (SMALL + SM_LAM)
#define SEL ((int*)(ws + WS_SEL))
#define RWBG ((u32x4*)(ws + WS_SMALL + 512 * 1024))
#define AFFL ((float*)(ws + WS_AFFL))
#define AFFC ((float*)(ws + WS_AFFC))
#define IDXROW ((int*)(ws + WS_IDX))
#define GATE ((float*)(ws + WS_GATE))
#define WINT ((bf16_t*)(ws + WS_WINT))
#define WBRT ((bf16_t*)(ws + WS_WBRT))
#define WOUTT ((bf16_t*)(ws + WS_WOUTT))
#define POOLT ((bf16_t*)(ws + WS_POOLT))
#define SGUW ((bf16_t*)(ws + WS_SGUW))
#define X ((bf16_t*)(ws + WS_X))
#define HX ((bf16_t*)(ws + WS_HX))
#define HX8 ((unsigned char*)(ws + WS_HX8))
#define WINT8 ((unsigned char*)(ws + WS_WINT8))
#define DP ((bf16_t*)(ws + WS_DP))
#define SVT ((bf16_t*)(ws + WS_SVT))
#define QD ((bf16_t*)(ws + WS_QD))
#define KD ((bf16_t*)(ws + WS_KD))
#define VD ((bf16_t*)(ws + WS_VD))
#define NQ ((bf16_t*)(ws + WS_NQ))
#define NK ((bf16_t*)(ws + WS_NK))
#define NV ((bf16_t*)(ws + WS_NV))
#define MACC ((float*)(ws + WS_MACC))
#define MB ((bf16_t*)(ws + WS_MB))
#define PZ ((bf16_t*)(ws + WS_PZ))
#define O0 ((float*)(ws + WS_O0))
#define SVTR ((bf16_t*)(ws + WS_SVTR))
#define SVST ((float*)(ws + WS_SVST))
#define SU ((bf16_t*)(ws + WS_SU))
#define SV ((bf16_t*)(ws + WS_SV))
#define NVT ((bf16_t*)(ws + WS_NVT))
#define V8T ((unsigned char*)(ws + WS_NVT))
#define BR ((bf16_t*)(ws + WS_BR))
#define GZ ((bf16_t*)(ws + WS_GZ))
#define W13T ((bf16_t*)(ws + WS_W13T))
#define W2T ((bf16_t*)(ws + WS_W2T))
#define XS ((bf16_t*)(ws + WS_XS))
#define HID ((bf16_t*)(ws + WS_HID))
#define Y ((unsigned char*)(ws + WS_Y))

#define PH_IDS() int tid_ = threadIdx.x; asm volatile("" : "+v"(tid_)); const int tid = tid_, lane = tid & 63, wave = __builtin_amdgcn_readfirstlane(tid >> 6); const int gw = vcu * NWAVES + wave, gt = vcu * 512 + tid; (void)gw; (void)gt; (void)lane
#ifndef PHMASK
#define PHMASK 0x1ffffffu
#endif
#define IN(k) (((PHMASK >> (k)) & 1u) && lo <= (k) && (k) < hi_ph)
#define SEAM(k) do { if (IN((k) + 1)) { if (MK_PER_PHASE) { } else xcd_barrier(bar); } } while (0)


#ifndef PROBE_MASK
#define PROBE_MASK 0u
#endif
#ifndef PROBE_SUB
#define PROBE_SUB 0u
#endif
#if ((PROBE_MASK) >> 0) & 1u
#define PH_LOOP_0 _Pragma("nounroll") for (int rep_ = 0; rep_ < 2; ++rep_)
#else
#define PH_LOOP_0
#endif
#if ((PROBE_MASK) >> 1) & 1u
#define PH_LOOP_1 _Pragma("nounroll") for (int rep_ = 0; rep_ < 2; ++rep_)
#else
#define PH_LOOP_1
#endif
#if ((PROBE_MASK) >> 2) & 1u
#define PH_LOOP_2 _Pragma("nounroll") for (int rep_ = 0; rep_ < 2; ++rep_)
#else
#define PH_LOOP_2
#endif
#if ((PROBE_MASK) >> 3) & 1u
#define PH_LOOP_3 _Pragma("nounroll") for (int rep_ = 0; rep_ < 2; ++rep_)
#else
#define PH_LOOP_3
#endif
#if ((PROBE_MASK) >> 4) & 1u
#define PH_LOOP_4 _Pragma("nounroll") for (int rep_ = 0; rep_ < 2; ++rep_)
#else
#define PH_LOOP_4
#endif
#if ((PROBE_MASK) >> 5) & 1u
#define PH_LOOP_5 _Pragma("nounroll") for (int rep_ = 0; rep_ < 2; ++rep_)
#else
#define PH_LOOP_5
#endif
#if ((PROBE_MASK) >> 6) & 1u
#define PH_LOOP_6 _Pragma("nounroll") for (int rep_ = 0; rep_ < 2; ++rep_)
#else
#define PH_LOOP_6
#endif
#if ((PROBE_MASK) >> 7) & 1u
#define PH_LOOP_7 _Pragma("nounroll") for (int rep_ = 0; rep_ < 2; ++rep_)
#else
#define PH_LOOP_7
#endif
#if ((PROBE_MASK) >> 8) & 1u
#define PH_LOOP_8 _Pragma("nounroll") for (int rep_ = 0; rep_ < 2; ++rep_)
#else
#define PH_LOOP_8
#endif
#if ((PROBE_MASK) >> 9) & 1u
#define PH_LOOP_9 _Pragma("nounroll") for (int rep_ = 0; rep_ < 2; ++rep_)
#else
#define PH_LOOP_9
#endif
#if ((PROBE_MASK) >> 10) & 1u
#define PH_LOOP_10 _Pragma("nounroll") for (int rep_ = 0; rep_ < 2; ++rep_)
#else
#define PH_LOOP_10
#endif
#if ((PROBE_MASK) >> 11) & 1u
#define PH_LOOP_11 _Pragma("nounroll") for (int rep_ = 0; rep_ < 2; ++rep_)
#else
#define PH_LOOP_11
#endif
#if ((PROBE_SUB) >> 0) & 1u
#define SUB_LOOP_0 _Pragma("nounroll") for (int reps_ = 0; reps_ < 2; ++reps_)
#else
#define SUB_LOOP_0
#endif
#if ((PROBE_SUB) >> 1) & 1u
#define SUB_LOOP_1 _Pragma("nounroll") for (int reps_ = 0; reps_ < 2; ++reps_)
#else
#define SUB_LOOP_1
#endif
#if ((PROBE_SUB) >> 2) & 1u
#define SUB_LOOP_2 _Pragma("nounroll") for (int reps_ = 0; reps_ < 2; ++reps_)
#else
#define SUB_LOOP_2
#endif
template <int l>
__device__ __forceinline__ void run_layer(const Args& args, LAS unsigned char* L, unsigned char* lds, const int G, const int bx, const int vcu, const int lo, const int hi_ph, const XcdBarrier& bar) {
    const int NGW = G * NWAVES, NGT = G * 512; (void)NGT;
        const int pb = 1 + 12 * l;
        const bool first = (l == 0);
        const float* MODL = MOD + l * 3 * 6144;
        const int nrows = first ? MROWS : MLAT;

        PH_LOOP_0 if (IN(pb + 0)) {
            PH_IDS();
            if (first) {
                for (int row = gw; row < MROWS; row += NGW) {
                    const bool isctx = row >= MLAT; const float* src = isctx ? args.in[I_CTX] + (size_t)(row - MLAT) * 1024 : args.in[I_X] + (size_t)row * 1024;
                    const float* md = MODL + (isctx ? 2 : (row >> 13)) * 6144;
                    f32x4 v[4]; load_row16(src, lane, v); const float rstd = row_rstd(v);
                    modulate_store2(v, rstd, args.in[I_N1G] + l * 1024, md, md + 1024, HX + (size_t)row * 1024, HX8 + (size_t)row * 1024, lane);
                }
                SEAM(pb + 0);
            }
        }
        PH_LOOP_1 if (IN(pb + 1)) {
            PH_IDS();
            { WinOrder S{G, bx, first ? 34 : 8, 1, 0, (const char*)HX8, (const char*)WINT8 + (size_t)l * INC * 1024, (size_t)256 * 1024};
              EpiWin E{QD, KD, SVTR, NQ, NK, (bf16_t*)SVST, SU, SV, GZ, PZ, ROPE, 1.f / 32.f, V8T};
              pg8::gemm_phase<EpiWin, WinOrder, true, true>(L, 512, S, E); }
            { WinOrder S{G, bx, first ? 34 : 8, 0, 1, (const char*)HX, (const char*)(WINT + (size_t)l * INC * 1024), (size_t)256 * 1024 * 2};
              EpiWin E{QD, KD, SVTR, NQ, NK, (bf16_t*)SVST, SU, SV, GZ, PZ, ROPE, 1.f, V8T};
              pg8::gemm_phase<EpiWin, WinOrder, true>(L, 1024, S, E); }
            SEAM(pb + 1);
        }
        PH_LOOP_3 if (IN(pb + 3)) {
            PH_IDS();
            const float lam = LAM[l]; const float lam_init = 0.8f - 0.6f * expf(-0.3f * (float)l);
            const int r32 = lane & 31, hi = lane >> 5;
#ifndef SKIP_P
            {
#define PZ8(p, a, b) do { const u32x4 w_ = *(const u32x4*)(p); a = (f32x4){bflo(w_.x), bfhi(w_.x), bflo(w_.y), bfhi(w_.y)}; b = (f32x4){bflo(w_.z), bfhi(w_.z), bflo(w_.w), bfhi(w_.w)}; } while (0)
            for (int i = gt; i < (nrows / 16) * 64; i += NGT) {
                const int rc = i >> 6, c8 = i & 63, g = c8 >> 4, half = 1 << g; const int row0 = rc * 16;
                int rb, t0, T; if (row0 < MLAT) { rb = row0 & ~8191; t0 = row0 & 8191; T = SEQ; } else { rb = MLAT + ((row0 - MLAT) & ~255); t0 = (row0 - MLAT) & 255; T = CTX; }
                const bf16_t* pz = PZ + (size_t)rb * 512 + c8 * 8;
                f32x4 s0 = {0.f, 0.f, 0.f, 0.f}, s1 = {0.f, 0.f, 0.f, 0.f}, a0, a1;
                for (int rr = max(t0 - half, 0); rr < min(t0 + half, T); ++rr) { PZ8(pz + (size_t)rr * 512, a0, a1); s0 += a0; s1 += a1; }
#pragma unroll 4
                for (int k = 0; k < 16; ++k) {
                    const int t = t0 + k; const int lo_t = max(t - half, 0), hi_t = min(t + half, T);
                    f32x4 z0, z1; PZ8(pz + (size_t)t * 512, z0, z1);
                    const float inv = 1.f / (float)(hi_t - lo_t);
                    const f32x4 d0 = s0 * inv - z0, d1 = s1 * inv - z1;
                    *(u32x4*)(DP + (size_t)(rb + t) * 512 + c8 * 8) = (u32x4){cvtpk(d0.x, d0.y), cvtpk(d0.z, d0.w), cvtpk(d1.x, d1.y), cvtpk(d1.z, d1.w)};
                    if (t + half < T) { PZ8(pz + (size_t)(t + half) * 512, a0, a1); s0 += a0; s1 += a1; }
                    if (t - half >= 0) { PZ8(pz + (size_t)(t - half) * 512, a0, a1); s0 -= a0; s1 -= a1; }
                }
            }
#undef PZ8
            }
#endif
#ifndef SKIP_A
            SUB_LOOP_0 {
                const int nun = 256 + (first ? 8 : 0);
                const int nit = 2 * ((nun - vcu + G - 1) / G);
#pragma nounroll
                for (int it = 0; it < nit; ++it) {
                    const int u = vcu + (it >> 1) * G, mm = it & 1;
                    const bool isctx = u >= 256; const int bh = isctx ? u - 256 : u >> 5, qb = isctx ? 0 : (u & 31);
                    const int b = bh >> 2, h = bh & 3; const int q0 = isctx ? 0 : CTX + qb * 256; const int seq = isctx ? CTX : NKEY;
                    const size_t hb = (size_t)((b * 4 + h) * 2 + mm) * NKEY * 64;
                    f32x16 o[4];
#ifndef ATTN_BF16
                    dattn8::body<0>((const unsigned char*)QD + hb + (size_t)q0 * 64, (const unsigned char*)KD + hb, V8T + (size_t)(b * 4 + h) * 128 * NKEY, seq, (char*)lds, o);
#else
                    dattn::body<0>(QD + hb + (size_t)q0 * 64, KD + hb, VD + (size_t)(b * 4 + h) * NKEY * 128, seq, (char*)lds, o);
#endif
                    int zo = 0; asm volatile("" : "+v"(zo));
                    float* o0p = O0 + (size_t)(vcu % 256) * 32768 + tid + zo;
                    if (mm == 0) {
#pragma unroll
                        for (int d = 0; d < 4; ++d)
#pragma unroll
                            for (int r = 0; r < 16; ++r) o0p[(d * 16 + r) * 512] = o[d][r];
                    } else {
                        float ssq[16];
#pragma unroll
                        for (int r = 0; r < 16; ++r) { float s = 0.f;
#pragma unroll
                            for (int d = 0; d < 4; ++d) { const float a = o0p[(d * 16 + r) * 512] - lam * o[d][r]; o[d][r] = a; s += a * a; }
                            ssq[r] = s; }
#pragma unroll
                        for (int off = 1; off < 32; off <<= 1)
#pragma unroll
                            for (int r = 0; r < 16; ++r) ssq[r] += __shfl_xor(ssq[r], off);
                        const size_t rowb = (isctx ? (size_t)MLAT + b * CTX : (size_t)b * SEQ + qb * 256) + wave * 32;
                        bf16_t* brp = BR + (size_t)1 * MROWS * 512 + rowb * 512 + h * 128 + r32 + zo;
                        const float* gp = args.in[I_SUBLN] + l * 128 + r32 + zo;
                        const float g0 = gp[0], g1 = gp[32], g2 = gp[64], g3 = gp[96];
#pragma unroll
                        for (int r = 0; r < 16; ++r) { const float sc = rsqrtf(ssq[r] * (1.f / 128.f) + EPS) * (1.f - lam_init);
                            bf16_t* rp = brp + (size_t)crow(r, hi) * 512;
                            rp[0] = (bf16_t)(cvtpk(o[0][r] * sc * g0, 0.f) & 0xffffu); rp[32] = (bf16_t)(cvtpk(o[1][r] * sc * g1, 0.f) & 0xffffu);
                            rp[64] = (bf16_t)(cvtpk(o[2][r] * sc * g2, 0.f) & 0xffffu); rp[96] = (bf16_t)(cvtpk(o[3][r] * sc * g3, 0.f) & 0xffffu); }
                    }
                }
            }
#ifdef PROBE_ATTN_VAR
            {
                PH_IDS();
                const int nit = 2 * ((256 - vcu + G - 1) / G);
#pragma nounroll
                for (int it = 0; it < nit; ++it) {
                    const int u = vcu + (it >> 1) * G, mm = it & 1; const int bh = u >> 5, qb = u & 31, b = bh >> 2, h = bh & 3;
                    const size_t hb = (size_t)((b * 4 + h) * 2 + mm) * NKEY * 64;
                    f32x16 o[4];
                    dattn8::body<PROBE_ATTN_VAR>((const unsigned char*)QD + hb + (size_t)(CTX + qb * 256) * 64, (const unsigned char*)KD + hb, V8T + (size_t)(b * 4 + h) * 128 * NKEY, NKEY, (char*)lds, o);
                    int zo = 0; asm volatile("" : "+v"(zo));
                    float* o0p = O0 + (size_t)(vcu % 256) * 32768 + tid + zo;
#pragma unroll
                    for (int d = 0; d < 4; ++d)
#pragma unroll
                        for (int r = 0; r < 16; ++r) o0p[(d * 16 + r) * 512] = o[d][r];
                }
            }
#endif
#endif
            __syncthreads();
#ifndef SKIP_B
            SUB_LOOP_1 {
                PH_IDS(); const int r32 = lane & 31, hi = lane >> 5; const int hl = wave & 3, half = wave >> 2;
                LAS float* wsc = (LAS float*)(L + 65536) + wave * 384;   LAS float* al_l = wsc; LAS float* sb = wsc + 32 + 48;
                char* Lg = (char*)lds;
                constexpr int NSTG = 32768, NKS = 16384;
                const unsigned char* NQ8 = (const unsigned char*)NQ; const unsigned char* NK8 = (const unsigned char*)NK; const unsigned char* NV8T = V8T + NV8T_OFF;
                const int mxs = 0x7F7F7F7F;
                const int nun = 512 + (first ? 16 : 0);
                for (int u = vcu; u < nun; u += G) {
                    const bool isctx = u >= 512; int b, hg, row0, gr = 0;
                    if (!isctx) { hg = u & 1; const int gri = u >> 1; b = gri >> 7; gr = gri & 127; row0 = b * SEQ + gr * 64; }
                    else { const int uc = u - 512; hg = uc & 1; const int cc = uc >> 1; b = cc >> 2; row0 = MLAT + b * CTX + (cc & 3) * 64; }
                    const int h = 4 * hg + hl;
                    i32x8 q8;
                    { const unsigned char* qp = NQ8 + (size_t)(row0 + 32 * half + r32) * 512 + h * 64 + 32 * hi; const u32x4 x0 = *reinterpret_cast<const u32x4*>(qp), x1 = *reinterpret_cast<const u32x4*>(qp + 16);
                      q8 = __builtin_bit_cast(i32x8, __builtin_shufflevector(x0, x1, 0, 1, 2, 3, 4, 5, 6, 7)); }
                    float M = -1e30f; f32x16 lacc = f32x16{}; f32x16 o[2]; o[0] = f32x16{}; o[1] = f32x16{};
                    int r0 = 0; unsigned mlo = 0u, mhi = 0u; int lboff = 0;
                    if (!isctx) {
                        r0 = min(max(gr - 4, 0), 120);
                        const int cq = 32 * half + r32, cs = min(max(cq - 8, 0), 48);
                        const unsigned long long mk = (0xffffull << cs) >> (4 * hi); mlo = (unsigned)mk; mhi = (unsigned)(mk >> 32);
                        lboff = 15 - cq + 4 * hi;
                        for (int i = lane; i < 248; i += 64) { const int ii = i / 31, dc = i % 31; sb[i] = 1.4426950408889634f * args.in[I_RPB][((size_t)(l * 8 + h) * 15 + (r0 + ii - gr + 7)) * 31 + dc]; }
                        LDS_WAIT();
                    }
                    const int toff = isctx ? 8 : 0, nt = 12 - toff;
                    const size_t kloc = (size_t)b * SEQ + (size_t)r0 * 64, kctx = (size_t)MLAT + b * CTX;
#define NA_KB(ti) ((ti) < 8 ? kloc + (size_t)(ti) * 64 : kctx + (size_t)((ti) - 8) * 64)
                    u32x4 sk[2], sv[2];
#define NA_SLOAD(ti) do { const size_t kb_ = NA_KB(ti); _Pragma("unroll") for (int q = 0; q < 2; ++q) { const int idx = tid + 512 * q; \
                        sk[q] = *(const u32x4*)(NK8 + (kb_ + (idx >> 4)) * 512 + hg * 256 + (idx & 15) * 16); sv[q] = *(const u32x4*)(NV8T + (size_t)(hg * 256 + (idx >> 2)) * MROWS + kb_ + (idx & 3) * 16); } } while (0)
#define NA_SWRITE(buf) do { _Pragma("unroll") for (int q = 0; q < 2; ++q) { const int idx = tid + 512 * q; \
                        { const int row = idx >> 4, ch = idx & 15; *(u32x4*)(Lg + (buf) * NSTG + (ch >> 2) * 4096 + row * 64 + (((ch & 3) ^ ((row >> 2) & 3)) << 4)) = sk[q]; } \
                        { const int vr = idx >> 2, c = idx & 3; *(u32x4*)(Lg + (buf) * NSTG + NKS + (vr >> 6) * 4096 + (vr & 63) * 64 + ((c ^ (((vr & 63) >> 2) & 3)) << 4)) = sv[q]; } } } while (0)
                    const int ka = r32 * 64 + (((2 * hi) ^ ((r32 >> 2) & 3)) << 4);
                    NA_SLOAD(toff); NA_SWRITE(0); __syncthreads();
#pragma nounroll
                    for (int t = 0; t < nt; ++t) {
                        const int ti = toff + t, buf = t & 1;
                        if (t + 1 < nt) NA_SLOAD(ti + 1);
                        const char* Ks = Lg + buf * NSTG + hl * 4096;
                        f32x16 p0, p1;
                        { const u32x4 x0 = *reinterpret_cast<const u32x4*>(Ks + ka), x1 = *reinterpret_cast<const u32x4*>(Ks + (ka ^ 16));
                          const u32x4 y0 = *reinterpret_cast<const u32x4*>(Ks + 2048 + ka), y1 = *reinterpret_cast<const u32x4*>(Ks + 2048 + (ka ^ 16));
                          const i32x8 k0 = __builtin_bit_cast(i32x8, __builtin_shufflevector(x0, x1, 0, 1, 2, 3, 4, 5, 6, 7)), k1 = __builtin_bit_cast(i32x8, __builtin_shufflevector(y0, y1, 0, 1, 2, 3, 4, 5, 6, 7));
                          const f32x16 z = f32x16{};
                          p0 = __builtin_amdgcn_mfma_scale_f32_32x32x64_f8f6f4(k0, q8, z, 0, 0, 0, mxs, 0, 0x7C7C7C7C);
                          p1 = __builtin_amdgcn_mfma_scale_f32_32x32x64_f8f6f4(k1, q8, z, 0, 0, 0, mxs, 0, 0x7C7C7C7C); }
                        na_smpv_fp8(p0, p1, Lg + buf * NSTG + NKS + hl * 4096, ka, r32, hi, (ti < 8) ? (const LAS float*)(sb + ti * 31 + lboff) : (const LAS float*)nullptr, mlo, mhi, M, lacc, o, al_l, mxs);
                        if (t + 1 < nt) NA_SWRITE(buf ^ 1);
                        __syncthreads();
                    }
#undef NA_KB
#undef NA_SLOAD
#undef NA_SWRITE
                    asm volatile("s_nop 7\n\ts_nop 7\n\ts_nop 7" : "+v"(o[0]), "+v"(o[1]), "+v"(lacc) :: "memory");
#pragma unroll
                    for (int r = 0; r < 16; ++r) { const float rl = __builtin_amdgcn_rcpf(lacc[r]); const size_t row = (size_t)row0 + 32 * half + crow(r, hi);
#pragma unroll
                        for (int d0 = 0; d0 < 2; ++d0) BR[(size_t)3 * MROWS * 512 + row * 512 + h * 64 + 32 * d0 + r32] = (bf16_t)(cvtpk(o[d0][r] * rl, 0.f) & 0xffffu); }
                }
            }
#endif
#ifndef SKIP_C
            SUB_LOOP_2 {
                PH_IDS(); const int r32 = lane & 31, hi = lane >> 5;
                const int wr = wave >> 1, wc = wave & 1; const int ntl = nrows / 128;
                LAS float* RS = (LAS float*)L; LAS float* RM = RS + 128; LAS float* C0 = RS + 256 + wave * 32;
                for (int u = vcu; u < ntl * 4; u += G) {
                    const int tl = u >> 2, g = u & 3;
                    __syncthreads();
                    if (tid < 128) {
                        const float* sp = SVST + ((size_t)tl * 128 + tid) * 16; float s1 = 0.f, s2 = 0.f;
#pragma unroll
                        for (int k = 0; k < 4; ++k) { const f32x4 w = *(const f32x4*)(sp + 4 * k); s1 += w.x + w.z; s2 += w.y + w.w; }
                        const float mean = s1 * (1.f / 512.f); const float var = fmaxf(s2 * (1.f / 512.f) - mean * mean, 0.f); const float rstd = rsqrtf(var + EPS);
                        RS[tid] = rstd; RM[tid] = rstd * mean;
                    }
                    __syncthreads();
                    f32x16 a0, a1; float c0;
                    small_tile_ln(SGUW + (size_t)(l * 4 + g) * 16384, 128, SVTR + (size_t)(g * 128) * MROWS + (size_t)tl * 128, MROWS, wr, wc, r32, hi, RS, RM, a0, a1, c0);
                    c0 += __shfl_xor(c0, 32);
                    if (hi == 0) C0[r32] = c0;
                    LDS_WAIT(); asm volatile("" ::: "memory");
                    const float gam0 = args.in[I_SGUG][l * 512 + g * 128 + 64 * wc + r32], gam1 = args.in[I_SGUG][l * 512 + g * 128 + 64 * wc + 32 + r32];
#pragma unroll
                    for (int r = 0; r < 16; ++r) { const int p = 32 * wr + crow(r, hi); const size_t row = (size_t)tl * 128 + p; const float c0p = C0[crow(r, hi)], bp = args.in[I_SGUB][l * 512 + g * 128 + p];
#pragma unroll
                        for (int j = 0; j < 2; ++j) { const int col = g * 128 + 64 * wc + 32 * j + r32; const float a = j ? a1[r] : a0[r];
                            const float y = bf2f(SU[row * 512 + col]) * ((j ? gam1 : gam0) * (a - c0p) + bp);
                            BR[(size_t)2 * MROWS * 512 + row * 512 + col] = (bf16_t)(cvtpk(y, 0.f) & 0xffffu); } }
                }
            }
#endif
            SEAM(pb + 3);
        }
        PH_LOOP_4 if (IN(pb + 4)) {
            PH_IDS();
            if (first) {
                const int vw = wave * G + vcu;
                if (vw < 512) {
                    const int r32 = lane & 31, hi = lane >> 5, rt = vw >> 5, ct = vw & 31;
                    f32x16 acc = f32x16{};
#pragma nounroll
                    for (int br = 0; br < 4; ++br) {
                        const bf16_t* ap = (br == 0 ? DP : BR + (size_t)br * MROWS * 512) + (size_t)(MLAT + 32 * rt + r32) * 512 + 8 * hi;
                        const bf16_t* bp = WBRT + ((size_t)(l * 4 + br) * 1024 + 32 * ct + r32) * 512 + 8 * hi;
#pragma unroll 8
                        for (int sk = 0; sk < 32; ++sk) acc = __builtin_amdgcn_mfma_f32_32x32x16_bf16(*reinterpret_cast<const bf16x8*>(ap + 16 * sk), *reinterpret_cast<const bf16x8*>(bp + 16 * sk), acc, 0, 0, 0);
#pragma unroll
                        for (int r = 0; r < 16; ++r) { const size_t row = (size_t)MLAT + 32 * rt + crow(r, hi); const unsigned char* gp = (const unsigned char*)GZ + ((size_t)(br * 32 + ct) * MROWS + row) * 32 + r32;
                            const float g = (float)gp[0];
                            if (br < 3) acc[r] *= g * __builtin_amdgcn_rcpf((float)gp[(size_t)32 * MROWS * 32]);
                            else MB[row * 1024 + 32 * ct + r32] = (bf16_t)(cvtpk(acc[r] * g * (1.f / 255.f), 0.f) & 0xffffu); }
                    }
                }
            }
            MergeOrder S{G, bx, 64, (const char*)BR, (const char*)(WBRT + (size_t)l * 4 * 1024 * 512), (const char*)DP};
            EpiMerge E{GZ, MB};
            pg8::gemm_phase<EpiMerge, MergeOrder, true>(L, 512, S, E);
            SEAM(pb + 4);
        }
        PH_LOOP_5 if (IN(pb + 5)) {
            PH_IDS();
            if (first) {
                const int vw = wave * G + vcu;
                if (vw < 512) {
                    const int r32 = lane & 31, hi = lane >> 5, rt = vw >> 5, ct = vw & 31;
                    f32x16 acc = f32x16{};
                    const bf16_t* ap = MB + (size_t)(MLAT + 32 * rt + r32) * 1024 + 8 * hi;
                    const bf16_t* bp = WOUTT + ((size_t)l * 1024 + 32 * ct + r32) * 1024 + 8 * hi;
#pragma unroll 8
                    for (int sk = 0; sk < 64; ++sk) acc = __builtin_amdgcn_mfma_f32_32x32x16_bf16(*reinterpret_cast<const bf16x8*>(ap + 16 * sk), *reinterpret_cast<const bf16x8*>(bp + 16 * sk), acc, 0, 0, 0);
                    const float g1 = MODL[2 * 6144 + 2048 + 32 * ct + r32];
#pragma unroll
                    for (int r = 0; r < 16; ++r) { const size_t rc = (size_t)32 * rt + crow(r, hi);
                        X[(MLAT + rc) * 1024 + 32 * ct + r32] = (bf16_t)(cvtpk(args.in[I_CTX][rc * 1024 + 32 * ct + r32] + g1 * acc[r], 0.f) & 0xffffu); }
                }
            }
            WoutOrder S{G, bx, 64, (const char*)MB, (const char*)(WOUTT + (size_t)l * 1024 * 1024)};
            EpiWout E{args.in[I_X], args.in[I_CTX], X, MODL, first ? 1 : 0};
            pg8::gemm_phase<EpiWout, WoutOrder, false>(L, 1024, S, E);
            SEAM(pb + 5);
        }
        PH_LOOP_6 if (IN(pb + 6)) {
            PH_IDS();
            const int r32 = lane & 31, hi = lane >> 5;
            LAS u32x4* RWB = (LAS u32x4*)L;
            LAS float* PSQ = (LAS float*)(L + 102400);
            LAS f32x4* PA = (LAS f32x4*)(L + 66048);
            {
                const u32x4* src = RWBG + (size_t)l * 4096; u32x4 t8[8];
#pragma unroll
                for (int i = 0; i < 8; ++i) t8[i] = src[tid + 512 * i];
#pragma unroll
                for (int i = 0; i < 8; ++i) RWB[tid + 512 * i] = t8[i];
            }
            __syncthreads();
            const int ntask = nrows / 32;
            u32x4 xs[8];
#define P6_LOAD(task_) do { const bf16_t* xr_ = X + (size_t)((task_) * 32 + r32) * 1024 + 128 * wave + 8 * hi; _Pragma("unroll") for (int ss = 0; ss < 8; ++ss) xs[ss] = *(const u32x4*)(xr_ + 16 * ss); } while (0)
            if (vcu < ntask) P6_LOAD(vcu);
            for (int task = vcu; task < ntask; task += G) {
                const int row0 = task * 32; const bool isctx = row0 >= MLAT; const float* md = MODL + (isctx ? 2 : (row0 >> 13)) * 6144;
                const float* n2g = args.in[I_N2G] + l * 1024;
                const bf16_t* xr = X + (size_t)(row0 + r32) * 1024; unsigned char* hxr = HX8 + (size_t)(row0 + r32) * 1024;
                float qs = 0.f;
#pragma unroll
                for (int ss = 0; ss < 8; ++ss) { const u32x4 w = xs[ss]; const float e0 = bflo(w.x), e1 = bfhi(w.x), e2 = bflo(w.y), e3 = bfhi(w.y), e4 = bflo(w.z), e5 = bfhi(w.z), e6 = bflo(w.w), e7 = bfhi(w.w);
                    qs += ((e0 * e0 + e1 * e1) + (e2 * e2 + e3 * e3)) + ((e4 * e4 + e5 * e5) + (e6 * e6 + e7 * e7)); }
                qs += __shfl_xor(qs, 32);
                if (hi == 0) PSQ[wave * 32 + r32] = qs;
                __syncthreads();
                float tot = 0.f;
#pragma unroll
                for (int w = 0; w < 8; ++w) tot += PSQ[w * 32 + r32];
                const float rs = rsqrtf(tot * (1.f / D) + EPS);
                f32x16 acc = f32x16{};
#pragma unroll
                for (int ss = 0; ss < 8; ++ss) {
                    const int c0 = 128 * wave + 16 * ss + 8 * hi;
                    const u32x4 xw = xs[ss]; const f32x4 x0 = (f32x4){bflo(xw.x), bfhi(xw.x), bflo(xw.y), bfhi(xw.y)}, x1 = (f32x4){bflo(xw.z), bfhi(xw.z), bflo(xw.w), bfhi(xw.w)};
                    const f32x4 g0 = *(const f32x4*)(n2g + c0), g1 = *(const f32x4*)(n2g + c0 + 4);
                    const f32x4 s0 = *(const f32x4*)(md + 4096 + c0), s1 = *(const f32x4*)(md + 4096 + c0 + 4);
                    const f32x4 b0 = *(const f32x4*)(md + 3072 + c0), b1 = *(const f32x4*)(md + 3072 + c0 + 4);
                    const f32x4 h0 = x0 * rs * g0 * (1.f + s0) + b0, h1 = x1 * rs * g1 * (1.f + s1) + b1;
                    const u32x4 hw = (u32x4){cvtpk(h0.x, h0.y), cvtpk(h0.z, h0.w), cvtpk(h1.x, h1.y), cvtpk(h1.z, h1.w)};
                    *(u32x2*)(hxr + c0) = (u32x2){cvt4_fp8s(h0.x, h0.y, h0.z, h0.w), cvt4_fp8s(h1.x, h1.y, h1.z, h1.w)};
                    const u32x4 lw = (u32x4){cvtpk(h0.x - bflo(hw.x), h0.y - bfhi(hw.x)), cvtpk(h0.z - bflo(hw.y), h0.w - bfhi(hw.y)), cvtpk(h1.x - bflo(hw.z), h1.y - bfhi(hw.z)), cvtpk(h1.z - bflo(hw.w), h1.w - bfhi(hw.w))};
                    const bf16x8 bfr = __builtin_bit_cast(bf16x8, RWB[(8 * wave + ss) * 64 + lane]);
                    acc = __builtin_amdgcn_mfma_f32_32x32x16_bf16(__builtin_bit_cast(bf16x8, hw), bfr, acc, 0, 0, 0);
                    acc = __builtin_amdgcn_mfma_f32_32x32x16_bf16(__builtin_bit_cast(bf16x8, lw), bfr, acc, 0, 0, 0);
                }
#pragma unroll
                for (int q = 0; q < 4; ++q) PA[(wave * 4 + q) * 64 + lane] = (f32x4){acc[4 * q], acc[4 * q + 1], acc[4 * q + 2], acc[4 * q + 3]};
                if (task + G < ntask) P6_LOAD(task + G);
                __syncthreads();
                {
                    const LAS float* PAf = (const LAS float*)PA;
#pragma unroll
                    for (int jj = 0; jj < 2; ++jj) {
                        const int r = 2 * wave + jj, q = r >> 2, cp = r & 3; float t = 0.f;
#pragma unroll
                        for (int w = 0; w < 8; ++w) t += PAf[((w * 4 + q) * 64 + lane) * 4 + cp];
                        t += __shfl_xor(t, 16);
                        float mx = t;
#pragma unroll
                        for (int o = 1; o < 16; o <<= 1) mx = fmaxf(mx, __shfl_xor(mx, o));
                        const float p = __expf(t - mx); float den = p;
#pragma unroll
                        for (int o = 1; o < 16; o <<= 1) den += __shfl_xor(den, o);
                        if (r32 < 16) { const int rr = row0 + crow(r, hi);
                            float* ap = isctx ? AFFC + (size_t)(((rr - MLAT) >> 8) * 16 + r32) * CTX + ((rr - MLAT) & 255) : AFFL + (size_t)((rr >> 13) * 16 + r32) * SEQ + (rr & 8191);
                            *ap = p / den; }
                    }
                }
                __syncthreads();
            }
#undef P6_LOAD
            SEAM(pb + 6);
        }
        PH_LOOP_7 if (IN(pb + 7)) {
            PH_IDS();
            const int nlist = first ? 64 : 32;
            for (int li = vcu; li < nlist; li += G) {
                if (li < 32) { const int b = li >> 4, e = li & 15; topk_list((LAS unsigned*)L, AFFL + (size_t)li * SEQ, SEQ, CAP, b * SEQ, e, b * CAP, IDXROW, GATE, SEL); }
                else { const int lc = li - 32, b = lc >> 4, e = lc & 15; topk_list((LAS unsigned*)L, AFFC + (size_t)lc * CTX, CTX, CAPC, MLAT + b * CTX, e, 2 * CAP + b * CAPC, IDXROW, GATE, SEL); }
            }
            LAS float* scr = (LAS float*)(L + wave * 16384);
            const int nA = (nlist < G ? nlist : 0) * 64, wv = vcu * NWAVES + wave;
            const int it0 = (vcu < nlist && nA) ? wv : nA + (wv - (nA ? nlist * NWAVES : 0)), its = (vcu < nlist && nA) ? nlist * NWAVES : (G - (nA ? nlist : 0)) * NWAVES, ite = (vcu < nlist && nA) ? nA : 16 * 1536;
            for (int it = it0; it < ite; it += its) {
                const int e = it / 1536; int r = it % 1536;
                const size_t wo = ((size_t)l * 16 + e) * 1024 * 1024;
                if (r < 512) { const int nb = r % 32, n0 = 32 * nb; transpose_item_fp8(args.in[I_W1] + wo, 1024, 1024, (unsigned char*)W13T + (size_t)e * 2048 * 1024, r / 32, nb, 256 * (n0 >> 7) + (n0 & 127), 32.f, scr, lane); continue; } r -= 512;
                if (r < 512) { const int nb = r % 32, n0 = 32 * nb; transpose_item_fp8(args.in[I_W3] + wo, 1024, 1024, (unsigned char*)W13T + (size_t)e * 2048 * 1024, r / 32, nb, 256 * (n0 >> 7) + 128 + (n0 & 127), 32.f, scr, lane); continue; } r -= 512;
                transpose_item_fp8(args.in[I_W2] + wo, 1024, 1024, (unsigned char*)W2T + (size_t)e * 1024 * 1024, r / 32, r % 32, 32 * (r % 32), 32.f, scr, lane);
            }
            SEAM(pb + 7);
        }
        const int nslot = first ? 2 * CAP + 2 * CAPC : 2 * CAP;
        PH_LOOP_9 if (IN(pb + 9)) {
            PH_IDS();
            MoeOrder S{G, bx, first ? 9 : 8, 8, (const char*)HX8, (const char*)W13T, (size_t)256 * 1024, IDXROW, MROWS - 1};
            EpiW13 E{(unsigned char*)HID};
            pg8::gemm_phase<EpiW13, MoeOrder, true, true, true>(L, 512, S, E);
            SEAM(pb + 9);
        }
        PH_LOOP_10 if (IN(pb + 10)) {
            PH_IDS();
            MoeOrder S{G, bx, first ? 9 : 8, 4, (const char*)HID, (const char*)W2T, (size_t)256 * 1024, nullptr, 0};
            EpiW2 E{Y, GATE};
            pg8::gemm_phase<EpiW2, MoeOrder, true, true>(L, 512, S, E);
            SEAM(pb + 10);
        }
        PH_LOOP_11 if (IN(pb + 11)) {
            PH_IDS();
            for (int row = gw; row < nrows; row += NGW) {
                const bool isctx = row >= MLAT; const int mr = isctx ? 2 : (row >> 13); const float* md = MODL + mr * 6144;
                f32x4 v[4]; load_row16_bf(X + (size_t)row * 1024, lane, v);
                f32x4 ys[4];
#pragma unroll
                for (int j = 0; j < 4; ++j) ys[j] = (f32x4){0.f, 0.f, 0.f, 0.f};
                const int sv = (lane < 16) ? SEL[(size_t)lane * MROWS + row] : -1;
                for (int e = 0; e < 16; ++e) { const int s = __shfl(sv, e);
                    if (s >= 0) { const unsigned char* yp = Y + (size_t)(e * ESLOT + s) * 1024;
#pragma unroll
                        for (int j = 0; j < 4; ++j) { const unsigned w = *(const unsigned*)(yp + 4 * lane + 256 * j); const auto lo = __builtin_amdgcn_cvt_pk_f32_fp8((int)w, false), hi2 = __builtin_amdgcn_cvt_pk_f32_fp8((int)w, true); ys[j] += (f32x4){lo[0], lo[1], hi2[0], hi2[1]}; } } }
#pragma unroll
                for (int j = 0; j < 4; ++j) v[j] += *(const f32x4*)(md + 5120 + 4 * lane + 256 * j) * ys[j] * (1.f / 128.f);
                const float rstd = row_rstd(v);
                if (first) {
#pragma unroll
                    for (int j = 0; j < 4; ++j) *(u32x2*)(X + (size_t)row * 1024 + 4 * lane + 256 * j) = (u32x2){cvtpk(v[j].x, v[j].y), cvtpk(v[j].z, v[j].w)};
                    const float* md1 = MOD + (3 + mr) * 6144;
                    modulate_store2(v, rstd, args.in[I_N1G] + 1024, md1, md1 + 1024, HX + (size_t)row * 1024, HX8 + (size_t)row * 1024, lane);
                } else {
#pragma unroll
                    for (int j = 0; j < 4; ++j) { const int c = 4 * lane + 256 * j; *(f32x4*)(args.out + (size_t)row * 1024 + c) = v[j] * rstd * *(const f32x4*)(args.in[I_FING] + c); }
                }
            }
            SEAM(pb + 11);
        }
    }

__global__ void __launch_bounds__(NWAVES * 64, 2) mega_fwd(Args args) {
    extern __shared__ __attribute__((aligned(16))) unsigned char lds[];
    LAS unsigned char* L = (LAS unsigned char*)lds;
    volatile LAS unsigned* MISC = (volatile LAS unsigned*)(L + MISC_OFF);
    const int tid = threadIdx.x, lane = tid & 63, wave = __builtin_amdgcn_readfirstlane(tid >> 6);
    const int G = gridDim.x; const int bx = blockIdx.x; const int vcu = (G % 8 == 0) ? (bx % 8) * (G / 8) + bx / 8 : bx;
    const int NGW = G * NWAVES, NGT = G * 512;
    for (int u = tid; u < (LDS_BYTES - RING_BYTES) / 4; u += NWAVES * 64) ((LAS unsigned*)(L + RING_BYTES))[u] = 0u;
    __syncthreads();
    XcdBarrier bar; bar.bar = ctl + 4096; bar.x = 0; bar.st = nullptr;
    if (!MK_PER_PHASE) bar = xcd_barrier_post(ctl + 4096, MISC + 8);
    const int lo = args.ph_lo, hi_ph = args.ph_hi;
    if (IN(0)) {
        PH_IDS();
        LAS float* scr = (LAS float*)(L + wave * 16384);
        for (int it = gw; it < 2 * 5920; it += NGW) {
            const int l = it / 5920; int r = it % 5920;
            if (r < 4352) { if (((WIN_FP8_MASK >> ((r % 272) >> 3)) & 1ull) == 0ull) transpose_item(args.in[I_WIN] + (size_t)l * 1024 * INC, 1024, INC, WINT + (size_t)l * INC * 1024, r / 272, r % 272, 32 * (r % 272), scr, lane);
                else transpose_item_fp8(args.in[I_WIN] + (size_t)l * 1024 * INC, 1024, INC, WINT8 + (size_t)l * INC * 1024, r / 272, r % 272, 32 * (r % 272), 32.f, scr, lane);
                continue; } r -= 4352;
            if (r < 1024) { const int i = r >> 8, q = r & 255; if (i != 0) transpose_item(args.in[I_WBR] + (size_t)(l * 4 + i) * 512 * 1024, 512, 1024, WBRT + (size_t)(l * 4 + i) * 1024 * 512, q / 32, q % 32, 32 * (q % 32), scr, lane); continue; } r -= 1024;
            if (r < 512) { transpose_item(args.in[I_WOUT] + (size_t)l * 1024 * 1024, 1024, 1024, WOUTT + (size_t)l * 1024 * 1024, r / 32, r % 32, 32 * (r % 32), scr, lane); continue; } r -= 512;
            { }
        }
        for (int i = gt; i < 2 * 512 * 256; i += NGT) {
            const int l = i / (512 * 256), r = i % (512 * 256), k = r >> 8, n4 = (r & 255) * 4, g = k >> 7, c = k & 127;
            const float* wp = args.in[I_POOLW] + ((size_t)(l * 4 + g) * 128 + c) * 128; const float* sc = args.in[I_POOLS] + l * 512 + g * 128;
            const float* wb = args.in[I_WBR] + ((size_t)(l * 4) * 512 + g * 128) * 1024 + n4;
            f32x4 acc = {0.f, 0.f, 0.f, 0.f};
#pragma unroll 8
            for (int e = 0; e < 128; ++e) acc += (wp[e] * sc[e]) * *(const f32x4*)(wb + (size_t)e * 1024);
            bf16_t* dst = WBRT + ((size_t)(l * 4) * 1024 + n4) * 512 + k;
            dst[0] = (bf16_t)(cvtpk(acc.x, 0.f) & 0xffffu); dst[512] = (bf16_t)(cvtpk(acc.y, 0.f) & 0xffffu); dst[1024] = (bf16_t)(cvtpk(acc.z, 0.f) & 0xffffu); dst[1536] = (bf16_t)(cvtpk(acc.w, 0.f) & 0xffffu);
        }
        for (int i = gt; i < 2 * 4096; i += NGT) {
            const int l = i >> 12, idx = i & 4095, sidx = idx >> 6, ln = idx & 63, n = ln & 31, hh = ln >> 5; const float* wp = args.in[I_RW] + (size_t)l * 16384 + (size_t)(16 * sidx + 8 * hh) * 16 + (n & 15);
            float w[8];
#pragma unroll
            for (int j = 0; j < 8; ++j) { const float v = wp[j * 16]; const float vh = bflo(cvtpk(v, 0.f)); w[j] = (n < 16) ? v : v - vh; }
            RWBG[i] = (u32x4){cvtpk(w[0], w[1]), cvtpk(w[2], w[3]), cvtpk(w[4], w[5]), cvtpk(w[6], w[7])};
        }
        for (int i = gt; i < 2 * 4 * 128 * 128 / 2; i += NGT) { const float a = args.in[I_SGUW][2 * i], b = args.in[I_SGUW][2 * i + 1]; ((unsigned*)SGUW)[i] = cvtpk(a, b); }
        for (int i = gt; i < 192 * 16; i += NGT) {
            const int pos = i >> 4, f = i & 15; const double inv = pow(10000.0, -(double)f / 16.0);
            const bool isrow = pos < 128; const double ang = (double)(isrow ? pos : pos - 128) * (double)(float)inv;
            const float cv = (float)cos(ang), sv = (float)sin(ang);
            if (isrow) { ROPE[pos * 16 + f] = cv; ROPE[2048 + pos * 16 + f] = sv; } else { ROPE[4096 + (pos - 128) * 16 + f] = cv; ROPE[5120 + (pos - 128) * 16 + f] = sv; }
        }
        if (gw < 2) { const float* lp = args.in[I_LAMP] + gw * 256; const float a = wave_sum(lp[lane] * lp[64 + lane]), b = wave_sum(lp[128 + lane] * lp[192 + lane]);
            const float lam_init = 0.8f - 0.6f * expf(-0.3f * (float)gw); if (lane == 0) LAM[gw] = expf(a) - expf(b) + lam_init; }
        __syncthreads();
        LAS float* red = (LAS float*)L; LAS float* SC = red + 8 * 3 * 64;
        for (int i = tid; i < 3072; i += 512) { const float cv = i < 2048 ? args.in[I_C][i] : args.in[I_CCTX][i - 2048]; SC[i] = cv * sigmoidf_(cv); }
        __syncthreads();
        for (int it = vcu; it < 2 * 96; it += G) {
            const int l = it / 96, j = (it % 96) * 64 + lane; const float* wm = args.in[I_WMOD] + (size_t)l * 1024 * 6144 + j + (size_t)(wave * 128) * 6144;
            float a0 = 0.f, a1 = 0.f, a2 = 0.f;
#pragma nounroll
            for (int kb = 0; kb < 128; kb += 32) {
                float w[32];
#pragma unroll
                for (int q = 0; q < 32; ++q) w[q] = wm[(size_t)(kb + q) * 6144];
#pragma unroll
                for (int q = 0; q < 32; ++q) { const int k = wave * 128 + kb + q; a0 += SC[k] * w[q]; a1 += SC[1024 + k] * w[q]; a2 += SC[2048 + k] * w[q]; }
            }
            red[(wave * 3 + 0) * 64 + lane] = a0; red[(wave * 3 + 1) * 64 + lane] = a1; red[(wave * 3 + 2) * 64 + lane] = a2;
            __syncthreads();
            if (wave < 3) { float sm = args.in[I_BMOD][l * 6144 + j];
#pragma unroll
                for (int w2 = 0; w2 < 8; ++w2) sm += red[(w2 * 3 + wave) * 64 + lane];
                MOD[(l * 3 + wave) * 6144 + j] = sm; }
            __syncthreads();
        }
        SEAM(0);
    }

    run_layer<0>(args, L, lds, G, bx, vcu, lo, hi_ph, bar);
    run_layer<1>(args, L, lds, G, bx, vcu, lo, hi_ph, bar);
#undef IN
#undef SEAM
}

#undef ws
#undef ctl
#undef SMALL
#undef MOD
#undef ROPE
#undef LAM
#undef SEL
#undef RWBG
#undef AFFL
#undef AFFC
#undef IDXROW
#undef GATE
#undef WINT
#undef WBRT
#undef WOUTT
#undef POOLT
#undef SGUW
#undef X
#undef HX
#undef HX8
#undef WINT8
#undef DP
#undef SVT
#undef QD
#undef KD
#undef VD
#undef NQ
#undef NK
#undef NV
#undef MACC
#undef MB
#undef PZ
#undef O0
#undef SVTR
#undef SVST
#undef SU
#undef SV
#undef NVT
#undef V8T
#undef BR
#undef GZ
#undef W13T
#undef W2T
#undef XS
#undef HID
#undef Y
extern "C" void kernel_launch(void* const* d_in, const int* in_sizes, int n_in, void* d_out, int out_size, void* d_ws, size_t ws_size, hipStream_t stream) {
    static int grid = 0;
    if (grid == 0) {
        if (n_in != 24 || out_size != MLAT * D || ws_size < WS_END) { fprintf(stderr, "kernel_launch: unexpected shapes: n_in %d out %d ws %zu (need %zu)\n", n_in, out_size, ws_size, (size_t)WS_END); grid = -1; return; }
        int dev = 0, cus = 0;
        if (hipGetDevice(&dev) != hipSuccess || hipDeviceGetAttribute(&cus, hipDeviceAttributeMultiprocessorCount, dev) != hipSuccess) { grid = -1; return; }
        if (hipFuncSetAttribute((const void*)mega_fwd, hipFuncAttributeMaxDynamicSharedMemorySize, LDS_BYTES) != hipSuccess) { fprintf(stderr, "kernel_launch: hipFuncSetAttribute failed\n"); grid = -1; return; }
        grid = cus;
    }
    if (grid < 0) return;
    (void)hipMemsetAsync((char*)d_ws + WS_CTL, 0, CTL_ZERO_BYTES, stream);
    Args a{};
    for (int i = 0; i < 24; ++i) a.in[i] = (const float*)d_in[i];
    a.out = (float*)d_out; a.ws = (unsigned char*)d_ws;
#if MK_PER_PHASE
#ifndef PROBE_DUP
#define PROBE_DUP 0u
#endif
    for (int p = 0; p < 25; ++p) { if (p == 13) continue; a.ph_lo = p; a.ph_hi = p + 1;
        for (int rep = 0; rep < (((PROBE_DUP >> p) & 1u) ? 2 : 1); ++rep) hipLaunchKernelGGL(mega_fwd, dim3(grid), dim3(NWAVES * 64), LDS_BYTES, stream, a); }
#else
    a.ph_lo = 0; a.ph_hi = 25;
    hipLaunchKernelGGL(mega_fwd, dim3(grid), dim3(NWAVES * 64), LDS_BYTES, stream, a);
#endif
    const hipError_t le = hipPeekAtLastError();
    if (le != hipSuccess) fprintf(stderr, "kernel_launch: launch failed: %s\n", hipGetErrorName(le));
}
```

```cpp
#include <hip/hip_runtime.h>
#include <hip/hip_bf16.h>
#include <cstdio>
#include <cstdint>

#ifndef MK_PER_PHASE
#define MK_PER_PHASE 0
#endif

#define LAS __attribute__((address_space(3)))
#define GAS __attribute__((address_space(1)))
typedef unsigned short bf16_t;
typedef short bf16x8 __attribute__((ext_vector_type(8)));
typedef short s16x4 __attribute__((ext_vector_type(4)));
typedef float f32x4 __attribute__((ext_vector_type(4)));
typedef float f32x16 __attribute__((ext_vector_type(16)));
typedef unsigned u32x4 __attribute__((ext_vector_type(4)));
typedef unsigned u32x2 __attribute__((ext_vector_type(2)));
typedef float f32x2_t __attribute__((ext_vector_type(2)));
typedef __bf16 bf16x2_t __attribute__((ext_vector_type(2)));

constexpr int D = 1024, BATCH = 2, SEQ = 8192, CTX = 256;
constexpr int MLAT = BATCH * SEQ, MCTX = BATCH * CTX, MROWS = MLAT + MCTX;
constexpr int INC = 8704;
constexpr int NKEY = CTX + SEQ;
constexpr int NE = 16, CAP = 1024, CAPC = 32, ESLOT = 2304;
constexpr float EPS = 1e-6f;

constexpr size_t MiB = 1u << 20;
constexpr size_t WS_CTL = 0, CTL_ZERO_BYTES = 64 * 1024;
constexpr size_t WS_SMALL = 1 * MiB;
constexpr size_t WS_SEL = 2 * MiB;
constexpr size_t WS_AFFL = 4 * MiB;
constexpr size_t WS_AFFC = 5 * MiB;
constexpr size_t WS_IDX = 5 * MiB + 256 * 1024;
constexpr size_t WS_GATE = 5 * MiB + 512 * 1024;
constexpr size_t WS_WINT = 6 * MiB;
constexpr size_t WS_WBRT = 40 * MiB;
constexpr size_t WS_WOUTT = 48 * MiB;
constexpr size_t WS_POOLT = 52 * MiB;
constexpr size_t WS_SGUW = 52 * MiB + 512 * 1024;
constexpr size_t WS_X = 53 * MiB;
constexpr size_t WS_HX = 119 * MiB;
constexpr size_t WS_DP = WS_HX;
constexpr size_t WS_SVT = WS_HX + 16896ull * 1024;
constexpr size_t WS_A = 152 * MiB;
constexpr size_t SZ16 = 16896ull * 1024;
constexpr size_t WS_QD = WS_A, WS_KD = WS_A + SZ16, WS_VD = WS_A + 2 * SZ16, WS_NQ = WS_A + 3 * SZ16, WS_NK = WS_A + 4 * SZ16, WS_NV = WS_A + 5 * SZ16;
constexpr size_t WS_MACC = WS_QD;
constexpr size_t WS_MB = WS_NK;
constexpr size_t WS_PZ = WS_A + 6 * SZ16;
constexpr size_t WS_O0 = WS_X + 33 * MiB;
constexpr size_t WS_SVTR = WS_VD;
constexpr size_t WS_SVST = WS_NV;
constexpr size_t WS_SU = WS_A + 8 * SZ16, WS_SV = WS_A + 9 * SZ16, WS_NVT = WS_A + 10 * SZ16;
constexpr size_t WS_BR = WS_A + 11 * SZ16;
constexpr size_t WS_GZ = WS_A + 15 * SZ16;
constexpr size_t WS_WINT8 = WS_GZ + 8 * SZ16;
constexpr size_t WS_HX8 = WS_WINT8 + 34 * MiB;
constexpr size_t WS_END = WS_HX8 + 17 * MiB;
constexpr size_t WS_W13T = WS_GZ;
constexpr size_t WS_W2T = WS_GZ + 64 * MiB;
constexpr size_t WS_XS = WS_A;
constexpr size_t WS_HID = WS_A + 72 * MiB;
constexpr size_t WS_Y = WS_A + 144 * MiB;
static_assert(WS_Y + 72 * MiB <= WS_GZ && WS_W2T + 32 * MiB <= WS_END, "moe alias map");
constexpr int SM_MOD = 0;
constexpr int SM_ROPE = 40960;
constexpr int SM_LAM = 48000;

__device__ __forceinline__ unsigned cvtpk(float lo, float hi) { f32x2_t v = {lo, hi}; bf16x2_t b = __builtin_convertvector(v, bf16x2_t); return __builtin_bit_cast(unsigned, b); }
typedef int i32x8 __attribute__((ext_vector_type(8)));
typedef int i32x4_t __attribute__((ext_vector_type(4)));
__device__ __forceinline__ unsigned cvt4_fp8(float a, float b, float c, float d) { int w = __builtin_amdgcn_cvt_pk_fp8_f32(a, b, 0, false); w = __builtin_amdgcn_cvt_pk_fp8_f32(c, d, w, true); return (unsigned)w; }
__device__ __forceinline__ unsigned cvt4_fp8n(float a, float b, float c, float d) { int w = __builtin_amdgcn_cvt_pk_fp8_f32(a, b, (int)__float_as_uint(a), false); w = __builtin_amdgcn_cvt_pk_fp8_f32(c, d, w, true); return (unsigned)w; }
__device__ __forceinline__ unsigned cvt4_fp8s(float a, float b, float c, float d) {
    return cvt4_fp8(__builtin_amdgcn_fmed3f(a, -448.f, 448.f), __builtin_amdgcn_fmed3f(b, -448.f, 448.f), __builtin_amdgcn_fmed3f(c, -448.f, 448.f), __builtin_amdgcn_fmed3f(d, -448.f, 448.f)); }
__device__ __forceinline__ float bf2f(unsigned short h) { return __uint_as_float(((unsigned)h) << 16); }
__device__ __forceinline__ float bflo(unsigned w) { return __uint_as_float(w << 16); }
__device__ __forceinline__ float bfhi(unsigned w) { return __uint_as_float(w & 0xffff0000u); }
__device__ __forceinline__ float wave_sum(float v) {
#pragma unroll
    for (int o = 1; o < 64; o <<= 1) v += __shfl_xor(v, o);
    return v;
}
__device__ __forceinline__ float sigmoidf_(float x) { return __builtin_amdgcn_rcpf(1.f + __expf(-x)); }
__device__ __forceinline__ float gelu_tanh(float x) { const float u = 1.5957691216057308f * (x + 0.044715f * x * x * x); return x * sigmoidf_(u); }
__device__ __forceinline__ int vkperm(int k) { return ((k & 4) << 3) | ((k & 32) >> 1) | ((k & 24) >> 1) | (k & 3); }
__device__ __forceinline__ int crow(int r, int hi) { return (r & 3) + 8 * (r >> 2) + 4 * hi; }
#define LDS_WAIT() asm volatile("s_waitcnt lgkmcnt(0)" ::: "memory")
#define VM_WAIT() asm volatile("s_waitcnt vmcnt(0)" ::: "memory")
#define SBAR() __builtin_amdgcn_sched_barrier(0)

struct Args { const float* in[24]; float* out; unsigned char* ws; int ph_lo, ph_hi; };
enum { I_X = 0, I_C, I_CTX, I_CCTX, I_WMOD, I_BMOD, I_N1G, I_N2G, I_WIN, I_POOLW, I_POOLS, I_LAMP, I_SUBLN, I_SGUG, I_SGUW, I_SGUB, I_RPB, I_WBR, I_WOUT, I_RW, I_W1, I_W3, I_W2, I_FING };

namespace pg8 {
constexpr int BM = 256, BK = 64, HALF = 128, HTB = HALF * BK * 2, STAGE_BYTES = 8 * HTB;
__host__ __device__ __forceinline__ int lds_byte(int r, int c) { const int st = (r >> 4) * 2 + (c >> 5), rr = r & 15, cc = c & 31, ob = rr * 64 + cc * 2; return st * 1024 + (ob ^ (((ob >> 9) & 1) << 5)); }
__host__ __device__ __forceinline__ void stage_rc(int b, int& R, int& C) { const int st = b / 1024, sb = b % 1024, swz = sb ^ (((sb >> 9) & 1) << 5); R = (st >> 1) * 16 + swz / 64; C = (st & 1) * 32 + (swz % 64) / 2; }
__host__ __device__ __forceinline__ int perm32(int rho) { const int n = rho >> 4, i = rho & 15; return 8 * (i >> 2) + 4 * n + (i & 3); }
struct Unit { int pm, pn, aux; const char* A; const char* B; };
__device__ __forceinline__ int xcd_remap(int L, int nwg) { const int q = nwg >> 3, r = nwg & 7, xcd = L & 7, off = L >> 3; return (xcd < r ? xcd * (q + 1) : r * (q + 1) + (xcd - r) * q) + off; }

template <class Epi, class Sched, bool ALIGN_EPI = false, bool FP8 = false, bool GATHER = false>
__device__ __forceinline__ void gemm_phase(LAS unsigned char* lds, const int K, const Sched& S, const Epi& E) {
    const int tid = threadIdx.x, wid = __builtin_amdgcn_readfirstlane(tid >> 6), lane = tid & 63, wr = wid >> 2, wc = wid & 3, fr = lane & 15, fq = lane >> 4;
    const int nt = K / BK;
    unsigned voffA[2], voffB[2];
#pragma unroll
    for (int i = 0; i < 2; ++i) { int R, C; stage_rc(tid * 16 + i * 8192, R, C); const int Rb = Epi::PERM ? ((R & ~31) + perm32(R & 31)) : R;
        voffA[i] = (unsigned)(R * K + C) * 2u; voffB[i] = (unsigned)(Rb * K + C) * 2u; }
    const size_t kstep = (size_t)(BK * 2);
    const size_t hstep = (size_t)HALF * K * 2;
    const unsigned ldsw = (unsigned)wid * 1024u;
    const int aoff = lds_byte(wr * 64 + fr, fq * 8), boff = lds_byte(wc * 32 + fr, fq * 8);
    const int aoff8a = lds_byte(wr * 64 + fr, fq * 16), boff8a = lds_byte(wc * 32 + fr, fq * 16);
#define PG8_SA(b, h) (((b) * 2 + (h)) * HTB)
#define PG8_SB(b, h) ((4 + (b) * 2 + (h)) * HTB)
#define PG8_STAGE(bufoff, gbase, voff) do { _Pragma("unroll") for (int _i = 0; _i < 2; ++_i) \
        __builtin_amdgcn_global_load_lds((const unsigned*)((const char*)(gbase) + (voff)[_i]), (LAS unsigned*)(lds + (bufoff) + ldsw + _i * 8192), 16, 0, 0); } while (0)
#define PG8_STAGE_G(bufoff, gbase, g) do { _Pragma("unroll") for (int _i = 0; _i < 2; ++_i) \
        __builtin_amdgcn_global_load_lds((const unsigned*)((const char*)(gbase) + (g)[_i]), (LAS unsigned*)(lds + (bufoff) + ldsw + _i * 8192), 16, 0, 0); } while (0)
#define PG8_GIDX(u, g) do { _Pragma("unroll") for (int _h = 0; _h < 2; ++_h) _Pragma("unroll") for (int _i = 0; _i < 2; ++_i) { int R_, C_; stage_rc(tid * 16 + _i * 8192, R_, C_); \
        int r_ = S.idx[(u).pm * 256 + _h * 128 + R_]; r_ = r_ < 0 ? 0 : (r_ > S.idx_max ? S.idx_max : r_); (g)[_h][_i] = (unsigned)r_ * (unsigned)(K * 2) + (unsigned)C_ * 2u; } } while (0)
#define PG8_LDA(dst, b, h) do { if constexpr (FP8) { _Pragma("unroll") for (int m = 0; m < 4; ++m) { const u32x4 x0_ = *(const LAS u32x4*)(lds + PG8_SA(b, h) + aoff8a + m * 2048), x1_ = *(const LAS u32x4*)(lds + PG8_SA(b, h) + aoff8a + 16 + m * 2048); \
        dst##8[m] = __builtin_bit_cast(i32x8, __builtin_shufflevector(x0_, x1_, 0, 1, 2, 3, 4, 5, 6, 7)); } } else { \
        _Pragma("unroll") for (int m = 0; m < 4; ++m) _Pragma("unroll") for (int k = 0; k < 2; ++k) dst[m][k] = *(const LAS bf16x8*)(lds + PG8_SA(b, h) + aoff + m * 2048 + k * 1024); } } while (0)
#define PG8_LDB(dst, b, h) do { if constexpr (FP8) { _Pragma("unroll") for (int n = 0; n < 2; ++n) { const u32x4 x0_ = *(const LAS u32x4*)(lds + PG8_SB(b, h) + boff8a + n * 2048), x1_ = *(const LAS u32x4*)(lds + PG8_SB(b, h) + boff8a + 16 + n * 2048); \
        dst##8[n] = __builtin_bit_cast(i32x8, __builtin_shufflevector(x0_, x1_, 0, 1, 2, 3, 4, 5, 6, 7)); } } else { \
        _Pragma("unroll") for (int n = 0; n < 2; ++n) _Pragma("unroll") for (int k = 0; k < 2; ++k) dst[n][k] = *(const LAS bf16x8*)(lds + PG8_SB(b, h) + boff + n * 2048 + k * 1024); } } while (0)
#define PG8_MMA(ai, bj, At, Bt) do { __builtin_amdgcn_s_setprio(1); if constexpr (FP8) { _Pragma("unroll") for (int m = 0; m < 4; ++m) _Pragma("unroll") for (int n = 0; n < 2; ++n) \
        asm("v_mfma_scale_f32_16x16x128_f8f6f4 %0, %1, %2, %0, %3, %3 op_sel_hi:[0,0,0]" : "+v"(acc[ai][bj][m][n]) : "v"(Bt##8[n]), "v"(At##8[m]), "v"(mxs)); } else { \
        _Pragma("unroll") for (int m = 0; m < 4; ++m) _Pragma("unroll") for (int n = 0; n < 2; ++n) _Pragma("unroll") for (int k = 0; k < 2; ++k) \
        acc[ai][bj][m][n] = __builtin_amdgcn_mfma_f32_16x16x32_bf16(Bt[n][k], At[m][k], acc[ai][bj][m][n], 0, 0, 0); } __builtin_amdgcn_s_setprio(0); } while (0)
#define PG8_WAIT_V(n) asm volatile("s_waitcnt vmcnt(" #n ")" ::: "memory")
#define PG8_WAIT_L(n) asm volatile("s_waitcnt lgkmcnt(" #n ")" ::: "memory")
#define PG8_BAR __builtin_amdgcn_s_barrier()
#define PG8_SCHED __builtin_amdgcn_sched_barrier(0)
    Unit cur, nxt; int ui = 0;
    if (!S.next(0, cur)) return;
    f32x4 acc[2][2][4][2];
#pragma unroll
    for (int a = 0; a < 2; ++a)
#pragma unroll
        for (int b = 0; b < 2; ++b)
#pragma unroll
            for (int m = 0; m < 4; ++m)
#pragma unroll
                for (int n = 0; n < 2; ++n) acc[a][b][m][n] = (f32x4){0.f, 0.f, 0.f, 0.f};
    bf16x8 At[4][2], B0[2][2], B1[2][2]; i32x8 At8[4], B08[2], B18[2]; const int mxs = 0x7F7F7F7F;
    const char* cA = cur.A; const char* cB = cur.B;
    unsigned gA[2][2], gN[2][2]; if constexpr (GATHER) { PG8_GIDX(cur, gA); }
    PG8_STAGE(PG8_SB(0, 0), cB, voffB); PG8_STAGE(PG8_SB(0, 1), cB + hstep, voffB);
    if constexpr (GATHER) { PG8_STAGE_G(PG8_SA(0, 0), cA, gA[0]); PG8_STAGE_G(PG8_SA(0, 1), cA, gA[1]); } else { PG8_STAGE(PG8_SA(0, 0), cA, voffA); PG8_STAGE(PG8_SA(0, 1), cA + hstep, voffA); }
    if (wr == 1) PG8_BAR;
    PG8_WAIT_V(2); PG8_BAR;
    PG8_STAGE(PG8_SB(1, 0), cB + kstep, voffB); if constexpr (GATHER) PG8_STAGE_G(PG8_SA(1, 0), cA + kstep, gA[0]); else PG8_STAGE(PG8_SA(1, 0), cA + kstep, voffA); PG8_STAGE(PG8_SB(1, 1), cB + hstep + kstep, voffB);
    PG8_WAIT_V(6); PG8_BAR;
    for (;;) {
        const bool has_next = S.next(ui + 1, nxt);
        const char* nA = has_next ? nxt.A : cA; const char* nB = has_next ? nxt.B : cB;
        if constexpr (GATHER) { if (has_next) { PG8_GIDX(nxt, gN); } else { gN[0][0] = gA[0][0]; gN[0][1] = gA[0][1]; gN[1][0] = gA[1][0]; gN[1][1] = gA[1][1]; } }
#pragma nounroll
        for (int t = 0; t < nt; t += 2) {
            const bool last = (t == nt - 2);
            const char* a1 = cA + (size_t)(t + 1) * kstep;
            const char* a2 = last ? nA : cA + (size_t)(t + 2) * kstep; const char* b2 = last ? nB : cB + (size_t)(t + 2) * kstep;
            const char* a3 = a2 + kstep; const char* b3 = b2 + kstep;
            unsigned g0_[2], g1_[2]; if constexpr (GATHER) { g0_[0] = last ? gN[0][0] : gA[0][0]; g0_[1] = last ? gN[0][1] : gA[0][1]; g1_[0] = last ? gN[1][0] : gA[1][0]; g1_[1] = last ? gN[1][1] : gA[1][1]; }
            PG8_LDB(B0, 0, 0); PG8_LDB(B1, 0, 1); PG8_SCHED; PG8_LDA(At, 0, 0); if constexpr (GATHER) PG8_STAGE_G(PG8_SA(1, 1), a1, gA[1]); else PG8_STAGE(PG8_SA(1, 1), a1 + hstep, voffA);
            PG8_WAIT_V(8); PG8_WAIT_L(0); PG8_BAR; PG8_MMA(0, 0, At, B0); PG8_MMA(0, 1, At, B1); PG8_BAR; PG8_SCHED;
            PG8_LDA(At, 0, 1); PG8_STAGE(PG8_SB(0, 0), b2, voffB); PG8_STAGE(PG8_SB(0, 1), b2 + hstep, voffB); if constexpr (GATHER) PG8_STAGE_G(PG8_SA(0, 0), a2, g0_); else PG8_STAGE(PG8_SA(0, 0), a2, voffA);
            PG8_WAIT_V(8); PG8_WAIT_L(0); PG8_BAR; PG8_MMA(1, 0, At, B0); PG8_MMA(1, 1, At, B1); PG8_BAR; PG8_SCHED;
            PG8_LDB(B0, 1, 0); PG8_LDB(B1, 1, 1); PG8_SCHED; PG8_LDA(At, 1, 0); if constexpr (GATHER) PG8_STAGE_G(PG8_SA(0, 1), a2, g1_); else PG8_STAGE(PG8_SA(0, 1), a2 + hstep, voffA);
            PG8_WAIT_V(8); PG8_WAIT_L(0); PG8_BAR; PG8_MMA(0, 0, At, B0); PG8_MMA(0, 1, At, B1); PG8_BAR; PG8_SCHED;
            PG8_LDA(At, 1, 1); PG8_STAGE(PG8_SB(1, 0), b3, voffB); PG8_STAGE(PG8_SB(1, 1), b3 + hstep, voffB); if constexpr (GATHER) PG8_STAGE_G(PG8_SA(1, 0), a3, g0_); else PG8_STAGE(PG8_SA(1, 0), a3, voffA);
            PG8_WAIT_V(8); PG8_WAIT_L(0); PG8_BAR; PG8_MMA(1, 0, At, B0); PG8_MMA(1, 1, At, B1); PG8_BAR; PG8_SCHED;
        }
        if constexpr (ALIGN_EPI) { if (wr == 0) PG8_BAR; }
        if constexpr (FP8) asm volatile("s_nop 15\n\ts_nop 15" ::: "memory");
        { int t2 = threadIdx.x; asm volatile("" : "+v"(t2)); const int fr2 = t2 & 15, fq2 = (t2 & 63) >> 4; E(acc, cur, wr, wc, fr2, fq2); }
        if (!has_next) break;
        if (!E.keep(cur)) {
#pragma unroll
        for (int a = 0; a < 2; ++a)
#pragma unroll
            for (int b = 0; b < 2; ++b)
#pragma unroll
                for (int m = 0; m < 4; ++m)
#pragma unroll
                    for (int n = 0; n < 2; ++n) acc[a][b][m][n] = (f32x4){0.f, 0.f, 0.f, 0.f};
        }
        cur = nxt; cA = nA; cB = nB; ++ui;
        if constexpr (GATHER) { gA[0][0] = gN[0][0]; gA[0][1] = gN[0][1]; gA[1][0] = gN[1][0]; gA[1][1] = gN[1][1]; }
        if constexpr (ALIGN_EPI) { if (wr == 1) PG8_BAR; }
    }
    PG8_WAIT_V(0);
    if constexpr (!ALIGN_EPI) { if (wr == 0) PG8_BAR; }
    PG8_BAR;
#undef PG8_SA
#undef PG8_SB
#undef PG8_STAGE
#undef PG8_STAGE_G
#undef PG8_GIDX
#undef PG8_LDA
#undef PG8_LDB
#undef PG8_MMA
#undef PG8_WAIT_V
#undef PG8_WAIT_L
#undef PG8_BAR
#undef PG8_SCHED
}
}
using pg8::Unit;
typedef f32x4 AccT[2][2][4][2];

#ifndef WIN_FP8_MASK
#define WIN_FP8_MASK 0x3FFFC0FFFull
#endif
struct WinOrder {
    int G, c, ncn, sel, rev; const char* A; const char* B; size_t tb;
    __device__ __forceinline__ int pn_of(int k, int lim) const { int q = -1; for (int p = 0; p < lim; ++p) { if ((int)((WIN_FP8_MASK >> p) & 1ull) == sel) { if (++q == k) return p; } } return 0; }
    __device__ __forceinline__ int count(int lim) const { int q = 0; for (int p = 0; p < lim; ++p) q += ((int)((WIN_FP8_MASK >> p) & 1ull) == sel) ? 1 : 0; return q; }
    __device__ __forceinline__ bool next(int i, Unit& u) const {
        const int cc = rev ? G - 1 - c : c; const int L = i * G + cc; const int n = count(34), nc = count(ncn); const int nlat = 64 * n;
        int k;
        if (L < nlat) { const int wgid = pg8::xcd_remap(L, nlat); const int nig = 8 * n, gid = wgid / nig, rem = wgid % nig; u.pm = gid * 8 + (rem & 7); k = rem >> 3; u.pn = pn_of(k, 34); }
        else if (L < nlat + 2 * nc) { const int Lc = L - nlat; u.pm = 64 + (Lc & 1); k = Lc >> 1; u.pn = pn_of(k, ncn); }
        else return false;
        u.aux = 0; u.A = A + (size_t)u.pm * tb; u.B = B + (size_t)u.pn * tb; return true;
    }
};
struct MergeOrder {
    int G, c, nM; const char* A; const char* B; const char* A0;
    __device__ __forceinline__ bool next(int i, Unit& u) const {
        const int j = i >> 2, br = i & 3; const int L = j * G + c, nwg = nM * 4; if (L >= nwg) return false;
        const int wgid = pg8::xcd_remap(L, nwg); u.pm = wgid >> 2; u.pn = wgid & 3; u.aux = br;
        u.A = (br == 0 ? A0 : A + (size_t)br * ((size_t)MROWS * 512 * 2)) + (size_t)u.pm * (256 * 512 * 2); u.B = B + (size_t)br * (1024 * 512 * 2) + (size_t)u.pn * (256 * 512 * 2); return true;
    }
};
struct WoutOrder {
    int G, c, nM; const char* A; const char* B;
    __device__ __forceinline__ bool next(int i, Unit& u) const {
        const int L = i * G + c, nwg = nM * 4; if (L >= nwg) return false;
        const int wgid = pg8::xcd_remap(L, nwg); u.pm = wgid >> 2; u.pn = wgid & 3; u.aux = 0;
        u.A = A + (size_t)u.pm * (256 * 1024 * 2); u.B = B + (size_t)u.pn * (256 * 1024 * 2); return true;
    }
};
struct MoeOrder {
    int G, c, nMe, nNe; const char* A; const char* B; size_t tb; const int* idx; int idx_max;
    __device__ __forceinline__ bool next(int i, Unit& u) const {
        const int L = i * G + c, per = nMe * nNe, nwg = NE * per; if (L >= nwg) return false;
        const int wgid = pg8::xcd_remap(L, nwg); const int e = wgid / per, rem = wgid % per; const int pmi = rem / nNe, pnj = rem % nNe;
        u.pm = e * 9 + pmi; u.pn = e * nNe + pnj; u.aux = e;
        u.A = idx ? A : A + (size_t)u.pm * tb; u.B = B + (size_t)u.pn * tb; return true;
    }
};

constexpr size_t NV8T_OFF = (size_t)8 * 128 * NKEY;
struct EpiWin {
    __device__ __forceinline__ bool keep(const Unit&) const { return false; }
    static constexpr bool PERM = true;
    bf16_t *QD, *KD, *VD, *NQ, *NK, *NV, *SU, *SV, *GZ; bf16_t* PZ;        const float* ROPE; float ascale; unsigned char* V8T_;
    template <int TYPE> __device__ __forceinline__ void run(AccT& acc, const Unit& u, int wr, int wc, int fr, int fq) const {
        const int pm = u.pm, pn = u.pn; const bool isctx = pm >= 64;
        const int b = isctx ? pm - 64 : pm >> 5, t0 = isctx ? 0 : (pm & 31) * 256, key0 = isctx ? 0 : CTX;
        const int cbase = (TYPE == 9) ? (pn - 18) * 256 : (pn & 1) * 256, cw = wc * 32 + 8 * fq;
#pragma unroll
        for (int ai = 0; ai < 2; ++ai) {
            f32x4 rtab[2][4];
#pragma unroll
            for (int m = 0; m < 4; ++m) {
                if constexpr (TYPE == 0 || TYPE == 4) {
                    if (!isctx && (m & 1) == 0) {
#pragma unroll
                        for (int mm = 0; mm < 2; ++mm) { const int tq = t0 + wr * 64 + fr + ai * 128 + (m + mm) * 16; const int part = wc & 1, pos = part ? (tq & 63) : (tq >> 6);
                            const float* cp = ROPE + (part ? 4096 : 0) + pos * 16 + (fq & 1) * 8; const float* sp = cp + (part ? 1024 : 2048);
                            rtab[mm][0] = *(const f32x4*)cp; rtab[mm][1] = *(const f32x4*)(cp + 4); rtab[mm][2] = *(const f32x4*)sp; rtab[mm][3] = *(const f32x4*)(sp + 4); }
                        asm volatile("" ::: "memory");
                    }
                }
                const int rl = wr * 64 + fr + ai * 128 + m * 16; const size_t row = (size_t)pm * 256 + rl; const int t = t0 + rl;
                float st1 = 0.f, st2 = 0.f;
#pragma unroll
                for (int bj = 0; bj < 2; ++bj) {
                    const int c = cbase + bj * 128 + cw;
                    float v[8];
#pragma unroll
                    for (int j = 0; j < 4; ++j) { v[j] = acc[ai][bj][m][0][j] * ascale; v[4 + j] = acc[ai][bj][m][1][j] * ascale; }
                    if constexpr (TYPE == 0 || TYPE == 4) {
                        if (!isctx) {
                            const f32x4 c0 = rtab[m & 1][0], c1 = rtab[m & 1][1], s0 = rtab[m & 1][2], s1 = rtab[m & 1][3];
                            const float sg = (fq < 2) ? -1.f : 1.f;
#pragma unroll
                            for (int j = 0; j < 8; ++j) { const float pv = __shfl_xor(v[j], 32); const float cc = j < 4 ? c0[j & 3] : c1[j & 3], ss = j < 4 ? s0[j & 3] : s1[j & 3]; v[j] = v[j] * cc + pv * (sg * ss); }
                        }
                        unsigned char* dst = (unsigned char*)(TYPE == 0 ? KD : QD) + ((size_t)((b * 4 + (c >> 7)) * 2 + ((c >> 6) & 1)) * NKEY + key0 + t) * 64 + (c & 63);
                        if constexpr (TYPE == 4) {
#pragma unroll
                            for (int j = 0; j < 8; ++j) v[j] *= 1.4426950408889634f;
                        }
                        *(u32x2*)dst = (u32x2){cvt4_fp8s(v[0], v[1], v[2], v[3]), cvt4_fp8s(v[4], v[5], v[6], v[7])};
                    } else if constexpr (TYPE == 1) {
                        unsigned char* dst = V8T_ + ((size_t)(b * 4 + (c >> 7)) * 128 + (c & 127)) * NKEY + key0 + (t & ~63) + vkperm(t & 63);
                        const unsigned w0 = cvt4_fp8s(v[0], v[1], v[2], v[3]), w1 = cvt4_fp8s(v[4], v[5], v[6], v[7]);
#pragma unroll
                        for (int j = 0; j < 8; ++j) dst[(size_t)j * NKEY] = (unsigned char)(((j < 4 ? w0 : w1) >> (8 * (j & 3))) & 255u);
                    } else if constexpr (TYPE == 6) {
                        *(u32x4*)(PZ + row * 512 + c) = (u32x4){cvtpk(v[0], v[1]), cvtpk(v[2], v[3]), cvtpk(v[4], v[5]), cvtpk(v[6], v[7])};
                    } else if constexpr (TYPE == 9) {
                        unsigned w0 = 0u, w1 = 0u; const float ne = -ascale * 1.4426950408889634f;
#pragma unroll
                        for (int j = 0; j < 4; ++j) {
                            const float y0 = fmaf(__builtin_amdgcn_rcpf(1.f + __builtin_amdgcn_exp2f(acc[ai][bj][m][0][j] * ne)), 255.f, -0.5f), y1 = fmaf(__builtin_amdgcn_rcpf(1.f + __builtin_amdgcn_exp2f(acc[ai][bj][m][1][j] * ne)), 255.f, -0.5f);
                            w0 = __builtin_amdgcn_cvt_pk_u8_f32(y0, j, w0); w1 = __builtin_amdgcn_cvt_pk_u8_f32(y1, j, w1); }
                        *(u32x2*)((unsigned char*)GZ + ((size_t)(c >> 5) * MROWS + row) * 32 + (c & 31)) = (u32x2){w0 + 0x01010101u, w1 + 0x01010101u};
                    } else if constexpr (TYPE == 2 || TYPE == 5) {
                        if constexpr (TYPE == 5) {
#pragma unroll
                            for (int j = 0; j < 8; ++j) v[j] *= 1.4426950408889634f;
                        }
                        *(u32x2*)((unsigned char*)(TYPE == 2 ? NK : NQ) + row * 512 + c) = (u32x2){cvt4_fp8s(v[0], v[1], v[2], v[3]), cvt4_fp8s(v[4], v[5], v[6], v[7])};
                    } else if constexpr (TYPE == 3) {
                        unsigned char* dst = V8T_ + NV8T_OFF + (size_t)c * MROWS + (row & ~(size_t)63) + vkperm((int)(row & 63));
                        const unsigned w0 = cvt4_fp8s(v[0], v[1], v[2], v[3]), w1 = cvt4_fp8s(v[4], v[5], v[6], v[7]);
#pragma unroll
                        for (int j = 0; j < 8; ++j) dst[(size_t)j * MROWS] = (unsigned char)(((j < 4 ? w0 : w1) >> (8 * (j & 3))) & 255u);
                    } else {
                        if constexpr (TYPE == 7 || TYPE == 8) {
#pragma unroll
                            for (int j = 0; j < 8; ++j) v[j] = gelu_tanh(v[j]);
                        }
                        if constexpr (TYPE == 8) {
                            bf16_t* dst = VD + (size_t)c * MROWS + row;
#pragma unroll
                            for (int j = 0; j < 8; ++j) { const unsigned hb = cvtpk(v[j], 0.f) & 0xffffu; const float vr = __uint_as_float(hb << 16); st1 += vr; st2 += vr * vr; dst[(size_t)j * MROWS] = (bf16_t)hb; }
                        } else {
                        bf16_t* base = TYPE == 7 ? SU : SV;
                        *(u32x4*)(base + row * 512 + c) = (u32x4){cvtpk(v[0], v[1]), cvtpk(v[2], v[3]), cvtpk(v[4], v[5]), cvtpk(v[6], v[7])};
                        }
                    }
                }
                if constexpr (TYPE == 8) {
                    st1 += __shfl_xor(st1, 16); st2 += __shfl_xor(st2, 16); st1 += __shfl_xor(st1, 32); st2 += __shfl_xor(st2, 32);
                    if (fq == 0) *(f32x2_t*)((float*)NV + (row * 8 + (pn & 1) * 4 + wc) * 2) = (f32x2_t){st1, st2};
                }
            }
        }
    }
    __device__ __forceinline__ void operator()(AccT& acc, const Unit& u, int wr, int wc, int fr, int fq) const {
#ifdef EPIWIN_ONLY
        const int ty = EPIWIN_ONLY;
#else
        const int ty = u.pn < 18 ? (u.pn >> 1) : 9;
#endif
        switch (ty) {
            case 0: run<0>(acc, u, wr, wc, fr, fq); break; case 1: run<1>(acc, u, wr, wc, fr, fq); break; case 2: run<2>(acc, u, wr, wc, fr, fq); break;
            case 3: run<3>(acc, u, wr, wc, fr, fq); break; case 4: run<4>(acc, u, wr, wc, fr, fq); break; case 5: run<5>(acc, u, wr, wc, fr, fq); break;
            case 6: run<6>(acc, u, wr, wc, fr, fq); break; case 7: run<7>(acc, u, wr, wc, fr, fq); break; case 8: run<8>(acc, u, wr, wc, fr, fq); break;
            default: run<9>(acc, u, wr, wc, fr, fq); break;
        }
    }
};
struct EpiMerge {
    static constexpr bool PERM = true;
    const bf16_t* GZ; bf16_t* MB;
    __device__ __forceinline__ bool keep(const Unit& u) const { return u.aux < 3; }
    __device__ __forceinline__ void operator()(AccT& acc, const Unit& u, int wr, int wc, int fr, int fq) const {
        const int br = u.aux;
        u32x2 gws[16], hws[16];
#pragma unroll
        for (int q = 0; q < 16; ++q) { const int ai = q >> 3, m = (q >> 1) & 3, bj = q & 1; const size_t row = (size_t)u.pm * 256 + wr * 64 + fr + ai * 128 + m * 16; const int col = u.pn * 256 + bj * 128 + wc * 32 + 8 * fq;
            const unsigned char* gp = (const unsigned char*)GZ + ((size_t)(br * 32 + (col >> 5)) * MROWS + row) * 32 + (col & 31);
            gws[q] = *(const u32x2*)gp; if (br < 3) hws[q] = *(const u32x2*)(gp + (size_t)32 * MROWS * 32); }
        asm volatile("" ::: "memory");
#pragma unroll
        for (int q16 = 0; q16 < 16; ++q16) { const int ai = q16 >> 3, m = (q16 >> 1) & 3, bj = q16 & 1; const size_t row = (size_t)u.pm * 256 + wr * 64 + fr + ai * 128 + m * 16; const int col = u.pn * 256 + bj * 128 + wc * 32 + 8 * fq;
            const u32x2 gw = gws[q16];
            float g[8];
#pragma unroll
            for (int q = 0; q < 8; ++q) g[q] = (float)(((q < 4 ? gw.x : gw.y) >> (8 * (q & 3))) & 255u);
            if (br < 3) {
                const u32x2 hw = hws[q16];
#pragma unroll
                for (int q = 0; q < 8; ++q) { const float h = (float)(((q < 4 ? hw.x : hw.y) >> (8 * (q & 3))) & 255u); acc[ai][bj][m][q >> 2][q & 3] *= g[q] * __builtin_amdgcn_rcpf(h); }
            } else {
                float v[8];
#pragma unroll
                for (int q = 0; q < 8; ++q) v[q] = acc[ai][bj][m][q >> 2][q & 3] * (g[q] * (1.f / 255.f));
                *(u32x4*)(MB + row * 1024 + col) = (u32x4){cvtpk(v[0], v[1]), cvtpk(v[2], v[3]), cvtpk(v[4], v[5]), cvtpk(v[6], v[7])};
            }
        }
    }
};
struct EpiWout {
    __device__ __forceinline__ bool keep(const Unit&) const { return false; }
    static constexpr bool PERM = true;
    const float* xlat; const float* xctx; bf16_t* X; const float* MODL; int first;
    __device__ __forceinline__ void operator()(AccT& acc, const Unit& u, int wr, int wc, int fr, int fq) const {
        const bool isctx = u.pm >= 64; const int mr = isctx ? 2 : (u.pm >> 5);
#pragma unroll
        for (int bj = 0; bj < 2; ++bj) {
            const int col = u.pn * 256 + bj * 128 + wc * 32 + 8 * fq;
            const f32x4 g0 = *(const f32x4*)(MODL + mr * 6144 + 2048 + col), g1 = *(const f32x4*)(MODL + mr * 6144 + 2048 + col + 4);
            f32x4 xa[8], xb[8]; u32x4 xw[8];
            if (first) {
#pragma unroll
                for (int q = 0; q < 8; ++q) { const size_t row = (size_t)u.pm * 256 + wr * 64 + fr + (q >> 2) * 128 + (q & 3) * 16; const float* src = (isctx ? xctx + (row - MLAT) * 1024 : xlat + row * 1024) + col; xa[q] = *(const f32x4*)src; xb[q] = *(const f32x4*)(src + 4); }
            } else {
#pragma unroll
                for (int q = 0; q < 8; ++q) { const size_t row = (size_t)u.pm * 256 + wr * 64 + fr + (q >> 2) * 128 + (q & 3) * 16; xw[q] = *(const u32x4*)(X + row * 1024 + col); }
                asm volatile("" ::: "memory");
#pragma unroll
                for (int q = 0; q < 8; ++q) { const u32x4 w = xw[q]; xa[q] = (f32x4){bflo(w.x), bfhi(w.x), bflo(w.y), bfhi(w.y)}; xb[q] = (f32x4){bflo(w.z), bfhi(w.z), bflo(w.w), bfhi(w.w)}; }
            }
#pragma unroll
            for (int q = 0; q < 8; ++q) { const int ai = q >> 2, m = q & 3; const size_t row = (size_t)u.pm * 256 + wr * 64 + fr + ai * 128 + m * 16;
                const f32x4 x0 = xa[q] + g0 * acc[ai][bj][m][0], x1 = xb[q] + g1 * acc[ai][bj][m][1];
                *(u32x4*)(X + row * 1024 + col) = (u32x4){cvtpk(x0.x, x0.y), cvtpk(x0.z, x0.w), cvtpk(x1.x, x1.y), cvtpk(x1.z, x1.w)}; }
        }
    }
};
struct EpiW13 {
    __device__ __forceinline__ bool keep(const Unit&) const { return false; }
    static constexpr bool PERM = true;
    unsigned char* HID;
    __device__ __forceinline__ void operator()(AccT& acc, const Unit& u, int wr, int wc, int fr, int fq) const {
        const int j = u.pn & 7;
#pragma unroll
        for (int ai = 0; ai < 2; ++ai)
#pragma unroll
            for (int m = 0; m < 4; ++m) {
                const size_t row = (size_t)u.pm * 256 + wr * 64 + fr + ai * 128 + m * 16;
                float h[8];
#pragma unroll
                for (int q = 0; q < 8; ++q) { const float a1 = acc[ai][0][m][q >> 2][q & 3], a3 = acc[ai][1][m][q >> 2][q & 3];
                    h[q] = (a1 * a3) * (__builtin_amdgcn_rcpf(1.f + __builtin_amdgcn_exp2f(a1 * (-1.4426950408889634f / 32.f))) * (4.f / 1024.f)); }
                *(u32x2*)(HID + row * 1024 + j * 128 + wc * 32 + 8 * fq) = (u32x2){cvt4_fp8s(h[0], h[1], h[2], h[3]), cvt4_fp8s(h[4], h[5], h[6], h[7])};
            }
    }
};
struct EpiW2 {
    __device__ __forceinline__ bool keep(const Unit&) const { return false; }
    static constexpr bool PERM = true;
    unsigned char* Y; const float* GATE;
    __device__ __forceinline__ void operator()(AccT& acc, const Unit& u, int wr, int wc, int fr, int fq) const {
        const int j = u.pn & 3;
        float gs[8];
#pragma unroll
        for (int q = 0; q < 8; ++q) gs[q] = GATE[(size_t)u.pm * 256 + wr * 64 + fr + (q >> 2) * 128 + (q & 3) * 16];
        asm volatile("" ::: "memory");
#pragma unroll
        for (int ai = 0; ai < 2; ++ai)
#pragma unroll
            for (int m = 0; m < 4; ++m) {
                const size_t row = (size_t)u.pm * 256 + wr * 64 + fr + ai * 128 + m * 16;
                const float g = gs[ai * 4 + m];
#pragma unroll
                for (int bj = 0; bj < 2; ++bj) {
                    const f32x4 v0 = acc[ai][bj][m][0] * g, v1 = acc[ai][bj][m][1] * g;
                    *(u32x2*)(Y + row * 1024 + j * 256 + bj * 128 + wc * 32 + 8 * fq) = (u32x2){cvt4_fp8s(v0[0], v0[1], v0[2], v0[3]), cvt4_fp8s(v1[0], v1[1], v1[2], v1[3])};
                }
            }
    }
};

namespace dattn {
constexpr int NW = 8, QBLK = 32, KVBLK = 64;
constexpr float SCALE = 0.125f;
constexpr float THR = 8.f;
constexpr int SHM_V = KVBLK * 128 * 2, SHM_K = KVBLK * 64 * 2;
constexpr int LDS_BYTES = 2 * SHM_V + 2 * SHM_K + NW * 64 * 4;
#define KSWZ64(row, colB) ((row) * 128 + ((colB) ^ ((((row) >> 1) & 7) << 4)))
template <int VAR> __device__ __forceinline__ void partialSM(f32x16& p0, f32x16& p1, float& m_reg, float& mn, float& alpha) {
    constexpr float C = SCALE * 1.4426950408889634f;
    float pmax = p0[0];
    if constexpr (VAR != 1) {
#pragma unroll
    for (int r = 1; r < 16; ++r) pmax = fmaxf(pmax, p0[r]);
#pragma unroll
    for (int r = 0; r < 16; ++r) pmax = fmaxf(pmax, p1[r]);
    } else pmax = m_reg;
    { auto rr = __builtin_amdgcn_permlane32_swap(__float_as_uint(pmax), __float_as_uint(pmax), false, false); pmax = fmaxf(__uint_as_float(rr[0]), __uint_as_float(rr[1])); }
    if (__builtin_expect(__all(pmax - m_reg <= THR / SCALE), 1)) { mn = m_reg; alpha = 1.f; }
    else { mn = fmaxf(m_reg, pmax); alpha = __builtin_amdgcn_exp2f((m_reg - mn) * C); m_reg = mn; }
    const float mnC = -mn * C;
#pragma unroll
    for (int r = 0; r < 16; ++r) p0[r] = fmaf(p0[r], C, mnC);
#pragma unroll
    for (int r = 0; r < 16; ++r) p1[r] = fmaf(p1[r], C, mnC);
#pragma unroll
    for (int r = 0; r < 16; ++r) p0[r] = (VAR == 2) ? p0[r] * 0.001f : __builtin_amdgcn_exp2f(p0[r]);
}
#define PK4(P, BASE, OUT) do { unsigned a0 = cvtpk(P[BASE + 0], P[BASE + 1]), a1 = cvtpk(P[BASE + 2], P[BASE + 3]);   \
    unsigned b0 = cvtpk(P[BASE + 4], P[BASE + 5]), b1 = cvtpk(P[BASE + 6], P[BASE + 7]);                              \
    auto r0 = __builtin_amdgcn_permlane32_swap(a0, b0, false, false); auto r1 = __builtin_amdgcn_permlane32_swap(a1, b1, false, false); \
    u32x4 w = {r0[0], r1[0], r0[1], r1[1]}; OUT = __builtin_bit_cast(bf16x8, w); } while (0)
template <int VAR> __device__ __forceinline__ void finishSM(f32x16& p0, f32x16& p1, float alpha, float& l_reg, bf16x8& pa0, bf16x8& pa1, bf16x8& pa2, bf16x8& pa3) {
#pragma unroll
    for (int r = 0; r < 16; ++r) p1[r] = (VAR == 2) ? p1[r] * 0.001f : __builtin_amdgcn_exp2f(p1[r]);
    float ps = 0;
#pragma unroll
    for (int r = 0; r < 16; ++r) ps += p0[r];
#pragma unroll
    for (int r = 0; r < 16; ++r) ps += p1[r];
    { auto rr = __builtin_amdgcn_permlane32_swap(__float_as_uint(ps), __float_as_uint(ps), false, false); ps = __uint_as_float(rr[0]) + __uint_as_float(rr[1]); }
    l_reg = l_reg * alpha + ps;
    PK4(p0, 0, pa0); PK4(p0, 8, pa1); PK4(p1, 0, pa2); PK4(p1, 8, pa3);
}
template <int VAR> __device__ __forceinline__ void qkt(f32x16& p0, f32x16& p1, const char* Ks, const bf16x8* qr, int r32, int hi) {
    p0 = f32x16{}; p1 = f32x16{};
    if constexpr (VAR == 4) { const float qv = __builtin_bit_cast(float, (int)qr[0][0] << 16); for (int r = 0; r < 16; ++r) { p0[r] = qv * (float)r; p1[r] = qv; } return; }
#pragma unroll
    for (int d0 = 0; d0 < 4; ++d0) { const int cb = (d0 * 16 + hi * 8) * 2;
        const bf16x8 b0 = *reinterpret_cast<const bf16x8*>(Ks + KSWZ64(r32, cb));
        const bf16x8 b1 = *reinterpret_cast<const bf16x8*>(Ks + KSWZ64(32 + r32, cb));
        p0 = __builtin_amdgcn_mfma_f32_32x32x16_bf16(b0, qr[d0], p0, 0, 0, 0);
        p1 = __builtin_amdgcn_mfma_f32_32x32x16_bf16(b1, qr[d0], p1, 0, 0, 0); }
}
__device__ __forceinline__ int v_st(int k, int c) { const int kk = (k & ~0xC) | ((k & 4) << 1) | ((k & 8) >> 1); return ((kk >> 3) * 4 + (c >> 5)) * 512 + ((kk & 7) * 32 + (c & 31)) * 2; }
__device__ __forceinline__ int v_rd_base(int lane) { return ((lane & 3) << 3) | (((lane >> 2) & 3) << 6) | (((lane >> 4) & 1) << 5) | (((lane >> 5) & 1) << 8); }
constexpr int v_rd_off(int d0, int ks, int half) { return d0 * 512 + ks * 4096 + half * 2048; }
template <int OFF> __device__ __forceinline__ s16x4 tr_read(int vb) { s16x4 r; asm volatile("ds_read_b64_tr_b16 %0, %1 offset:%2" : "=&v"(r) : "v"(vb), "i"(OFF) : "memory"); return r; }
template <int D0> __device__ __forceinline__ void pv_one(f32x16& od, int vb, bf16x8 pa0, bf16x8 pa1, bf16x8 pa2, bf16x8 pa3) {
    const s16x4 l0 = tr_read<v_rd_off(D0, 0, 0)>(vb), h0 = tr_read<v_rd_off(D0, 0, 1)>(vb), l1 = tr_read<v_rd_off(D0, 1, 0)>(vb), h1 = tr_read<v_rd_off(D0, 1, 1)>(vb);
    const s16x4 l2 = tr_read<v_rd_off(D0, 2, 0)>(vb), h2 = tr_read<v_rd_off(D0, 2, 1)>(vb), l3 = tr_read<v_rd_off(D0, 3, 0)>(vb), h3 = tr_read<v_rd_off(D0, 3, 1)>(vb);
    asm volatile("s_waitcnt lgkmcnt(0)" ::: "memory"); SBAR();
#define PKV(L, H) (bf16x8){L[0], L[1], L[2], L[3], H[0], H[1], H[2], H[3]}
    od = __builtin_amdgcn_mfma_f32_32x32x16_bf16(pa0, PKV(l0, h0), od, 0, 0, 0);
    od = __builtin_amdgcn_mfma_f32_32x32x16_bf16(pa1, PKV(l1, h1), od, 0, 0, 0);
    od = __builtin_amdgcn_mfma_f32_32x32x16_bf16(pa2, PKV(l2, h2), od, 0, 0, 0);
    od = __builtin_amdgcn_mfma_f32_32x32x16_bf16(pa3, PKV(l3, h3), od, 0, 0, 0);
#undef PKV
}
template <int D0> __device__ __forceinline__ void pv_rd(s16x4 (&v)[8], int vb) {
    v[0] = tr_read<v_rd_off(D0, 0, 0)>(vb); v[1] = tr_read<v_rd_off(D0, 0, 1)>(vb); v[2] = tr_read<v_rd_off(D0, 1, 0)>(vb); v[3] = tr_read<v_rd_off(D0, 1, 1)>(vb);
    v[4] = tr_read<v_rd_off(D0, 2, 0)>(vb); v[5] = tr_read<v_rd_off(D0, 2, 1)>(vb); v[6] = tr_read<v_rd_off(D0, 3, 0)>(vb); v[7] = tr_read<v_rd_off(D0, 3, 1)>(vb);
}
__device__ __forceinline__ void pv_mm(f32x16& od, const s16x4 (&v)[8], bf16x8 pa0, bf16x8 pa1, bf16x8 pa2, bf16x8 pa3) {
#define PKV(L, H) (bf16x8){L[0], L[1], L[2], L[3], H[0], H[1], H[2], H[3]}
    od = __builtin_amdgcn_mfma_f32_32x32x16_bf16(pa0, PKV(v[0], v[1]), od, 0, 0, 0);
    od = __builtin_amdgcn_mfma_f32_32x32x16_bf16(pa1, PKV(v[2], v[3]), od, 0, 0, 0);
    od = __builtin_amdgcn_mfma_f32_32x32x16_bf16(pa2, PKV(v[4], v[5]), od, 0, 0, 0);
    od = __builtin_amdgcn_mfma_f32_32x32x16_bf16(pa3, PKV(v[6], v[7]), od, 0, 0, 0);
#undef PKV
}
__device__ __forceinline__ void pv_pipe(f32x16* o, int vb, bf16x8 pa0, bf16x8 pa1, bf16x8 pa2, bf16x8 pa3) {
    s16x4 A[8], B[8];
    pv_rd<0>(A, vb); asm volatile("s_waitcnt lgkmcnt(0)" ::: "memory"); SBAR();
    pv_rd<1>(B, vb); SBAR(); pv_mm(o[0], A, pa0, pa1, pa2, pa3); asm volatile("s_waitcnt lgkmcnt(0)" ::: "memory"); SBAR();
    pv_rd<2>(A, vb); SBAR(); pv_mm(o[1], B, pa0, pa1, pa2, pa3); asm volatile("s_waitcnt lgkmcnt(0)" ::: "memory"); SBAR();
    pv_rd<3>(B, vb); SBAR(); pv_mm(o[2], A, pa0, pa1, pa2, pa3); asm volatile("s_waitcnt lgkmcnt(0)" ::: "memory"); SBAR();
    pv_mm(o[3], B, pa0, pa1, pa2, pa3);
}
template <int VAR> __device__ __forceinline__ void pv_d0(f32x16* o, int vb, bf16x8 pa0, bf16x8 pa1, bf16x8 pa2, bf16x8 pa3) {
    if constexpr (VAR == 6) { pv_pipe(o, vb, pa0, pa1, pa2, pa3); return; }
    if constexpr (VAR == 3) { o[0][0] += __builtin_bit_cast(float, (int)pa0[0] << 16) + __builtin_bit_cast(float, (int)pa3[7] << 16) + __builtin_bit_cast(float, (int)pa1[0] << 16) + __builtin_bit_cast(float, (int)pa2[0] << 16); return; }
    pv_one<0>(o[0], vb, pa0, pa1, pa2, pa3); pv_one<1>(o[1], vb, pa0, pa1, pa2, pa3); pv_one<2>(o[2], vb, pa0, pa1, pa2, pa3); pv_one<3>(o[3], vb, pa0, pa1, pa2, pa3);
}
template <int VAR> __device__ __forceinline__ void body(const bf16_t* __restrict__ Qb, const bf16_t* __restrict__ Kh, const bf16_t* __restrict__ Vh, int seq, char* lds, f32x16 (&o)[4]) {
    const int tid = threadIdx.x, wid = tid >> 6, lane = tid & 63, r32 = lane & 31, hi = lane >> 5;
    char* V_lds = lds; char* K_lds = lds + 2 * SHM_V;
    float* ws = (float*)(lds + 2 * SHM_V + 2 * SHM_K) + wid * 64; float* li_l = ws; float* al_l = ws + 32;
    float m_reg = -1e30f, l_reg = 0; bf16x8 qr[4];
#pragma unroll
    for (int d = 0; d < 4; ++d) o[d] = f32x16{};
    const bf16_t* Qw = Qb + (size_t)(wid * QBLK + r32) * 64 + hi * 8;
#pragma unroll
    for (int d0 = 0; d0 < 4; ++d0) qr[d0] = *reinterpret_cast<const bf16x8*>(Qw + d0 * 16);
    const int sr = tid >> 4, sc = (tid & 15) * 8, vst0 = v_st(sr, sc), vst1 = v_st(32 + sr, sc);
    const int kr = tid >> 3, kc = (tid & 7) * 8, kst = KSWZ64(kr, kc * 2);
    const int vb0 = (int)(uintptr_t)V_lds + v_rd_base(lane);
    struct { bf16x8 vs0, vs1, ks0; } sr_[2];
#define SLOAD(i, k0) do { sr_[i].vs0 = *reinterpret_cast<const bf16x8*>(&Vh[(size_t)((k0) + sr) * 128 + sc]); sr_[i].vs1 = *reinterpret_cast<const bf16x8*>(&Vh[(size_t)((k0) + 32 + sr) * 128 + sc]); \
    sr_[i].ks0 = *reinterpret_cast<const bf16x8*>(&Kh[(size_t)((k0) + kr) * 64 + kc]); } while (0)
#define SWRITE(b, i) do { *(bf16x8*)(V_lds + (b) * SHM_V + vst0) = sr_[i].vs0; *(bf16x8*)(V_lds + (b) * SHM_V + vst1) = sr_[i].vs1; *(bf16x8*)(K_lds + (b) * SHM_K + kst) = sr_[i].ks0; } while (0)
#define SWAIT() asm volatile("s_waitcnt vmcnt(3)" ::: "memory")
#define RESC(a) do { if (__any((a) < 1.f)) { if (hi == 0) al_l[r32] = (a); asm volatile("s_waitcnt lgkmcnt(0)" ::: "memory"); \
    _Pragma("unroll") for (int d = 0; d < 4; ++d) _Pragma("unroll") for (int r = 0; r < 16; ++r) o[d][r] *= al_l[crow(r, hi)]; } } while (0)
    f32x16 pA0, pA1, pB0, pB1; float mnA, mnB, alA, alB; bf16x8 pa0, pa1, pa2, pa3; const int NT = seq / KVBLK;
    constexpr int SE = 0, SO = 1;
    SLOAD(SE, 0); asm volatile("s_waitcnt vmcnt(0)" ::: "memory"); SWRITE(0, SE); __syncthreads();
    qkt<VAR>(pA0, pA1, K_lds, qr, r32, hi); partialSM<VAR>(pA0, pA1, m_reg, mnA, alA);
    SLOAD(SO, KVBLK); if (2 < NT) SLOAD(SE, 2 * KVBLK);
    SWAIT(); SWRITE(1, SO); __syncthreads();
    for (int j = 1; j + 1 < NT; j += 2) {
        SBAR(); qkt<VAR>(pB0, pB1, K_lds + SHM_K, qr, r32, hi);
        finishSM<VAR>(pA0, pA1, alA, l_reg, pa0, pa1, pa2, pa3); SBAR();
        SLOAD(SO, (j + 2) * KVBLK); SBAR();
        pv_d0<VAR>(o, vb0, pa0, pa1, pa2, pa3); partialSM<VAR>(pB0, pB1, m_reg, mnB, alB);
        __syncthreads(); SWAIT(); SWRITE(0, SE);
        RESC(alB); if constexpr (VAR != 5) __syncthreads();
        SBAR(); qkt<VAR>(pA0, pA1, K_lds, qr, r32, hi);
        finishSM<VAR>(pB0, pB1, alB, l_reg, pa0, pa1, pa2, pa3); SBAR();
        if (j + 3 < NT) SLOAD(SE, (j + 3) * KVBLK); SBAR();
        pv_d0<VAR>(o, vb0 + SHM_V, pa0, pa1, pa2, pa3); partialSM<VAR>(pA0, pA1, m_reg, mnA, alA);
        __syncthreads(); SWAIT(); SWRITE(1, SO);
        RESC(alA); if constexpr (VAR != 5) __syncthreads();
    }
    SBAR(); qkt<VAR>(pB0, pB1, K_lds + SHM_K, qr, r32, hi);
    finishSM<VAR>(pA0, pA1, alA, l_reg, pa0, pa1, pa2, pa3); SBAR();
    pv_d0<VAR>(o, vb0, pa0, pa1, pa2, pa3); partialSM<VAR>(pB0, pB1, m_reg, mnB, alB);
    __syncthreads(); RESC(alB);
    finishSM<VAR>(pB0, pB1, alB, l_reg, pa0, pa1, pa2, pa3); SBAR();
    pv_d0<VAR>(o, vb0 + SHM_V, pa0, pa1, pa2, pa3);
    if (hi == 0) li_l[r32] = l_reg; asm volatile("s_waitcnt lgkmcnt(0)" ::: "memory");
#pragma unroll
    for (int r = 0; r < 16; ++r) { const float rl = __builtin_amdgcn_rcpf(li_l[crow(r, hi)]);
#pragma unroll
        for (int d = 0; d < 4; ++d) o[d][r] *= rl; }
    asm volatile("s_waitcnt vmcnt(0) lgkmcnt(0)" ::: "memory"); __syncthreads();
#undef SLOAD
#undef SWRITE
#undef SWAIT
#undef RESC
}
}

namespace dattn8 {
constexpr int NW = 8, QBLK = 32, KVBLK = 64;
constexpr float THR2 = 3.f * 1.4426950408889634f;
constexpr int SHM_V = 128 * 64, SHM_K = KVBLK * 64;
constexpr int NRING = 3;
constexpr int LDS_BYTES = NRING * SHM_V + NRING * SHM_K + NW * 64 * 4;
template <bool FIRST> __device__ __forceinline__ void partialSM(f32x16& p0, f32x16& p1, float& M, float& alpha, f32x16& zc) {
    float pmax = -INFINITY;
#pragma unroll
    for (int r = 0; r < 16; ++r) pmax = fmaxf(pmax, p0[r]);
#pragma unroll
    for (int r = 0; r < 16; ++r) pmax = fmaxf(pmax, p1[r]);
    { auto rr = __builtin_amdgcn_permlane32_swap(__float_as_uint(pmax), __float_as_uint(pmax), false, false); pmax = __builtin_amdgcn_fmed3f(__uint_as_float(rr[0]), __uint_as_float(rr[1]), INFINITY); }
    alpha = 1.f;
    if (FIRST || !__builtin_expect(__all(pmax <= THR2 + 4.f), 1)) {
        const float delta = FIRST ? pmax - 4.f : fmaxf(pmax - 4.f, 0.f);
        M += delta; if (!FIRST) alpha = __builtin_amdgcn_exp2f(-delta);
#pragma unroll
        for (int r = 0; r < 16; ++r) { p0[r] -= delta; p1[r] -= delta; zc[r] -= delta; }
    }
#pragma unroll
    for (int r = 0; r < 16; ++r) p0[r] = __builtin_amdgcn_exp2f(p0[r]);
}
__device__ __forceinline__ void finishSM(f32x16& p0, f32x16& p1, i32x8& pa) {
#pragma unroll
    for (int r = 0; r < 16; ++r) p1[r] = __builtin_amdgcn_exp2f(p1[r]);
#pragma unroll
    for (int g = 0; g < 4; ++g) {
        pa[g] = (int)cvt4_fp8n(p0[4 * g], p0[4 * g + 1], p0[4 * g + 2], p0[4 * g + 3]); pa[4 + g] = (int)cvt4_fp8n(p1[4 * g], p1[4 * g + 1], p1[4 * g + 2], p1[4 * g + 3]);
    }
}
__device__ __forceinline__ void pv(f32x16 (&o)[4], f32x16& lacc, const char* Vs, int va, const i32x8& pa, int mxs, const char* ones_lds) {
#pragma unroll
    for (int d0 = 0; d0 < 4; ++d0) {
        const u32x4 x0 = *reinterpret_cast<const u32x4*>(Vs + d0 * 2048 + va), x1 = *reinterpret_cast<const u32x4*>(Vs + d0 * 2048 + (va ^ 16));
        const i32x8 bv = __builtin_bit_cast(i32x8, __builtin_shufflevector(x0, x1, 0, 1, 2, 3, 4, 5, 6, 7));
        if (d0 == 0) asm("s_nop 1\n\tv_mfma_scale_f32_32x32x64_f8f6f4 %0, %1, %2, %0, %3, %3 op_sel_hi:[0,0,0]" : "+v"(o[d0]) : "v"(pa), "v"(bv), "v"(mxs));
        else asm("v_mfma_scale_f32_32x32x64_f8f6f4 %0, %1, %2, %0, %3, %3 op_sel_hi:[0,0,0]" : "+v"(o[d0]) : "v"(pa), "v"(bv), "v"(mxs));
    }
    const u32x4 w1 = *reinterpret_cast<const u32x4*>(ones_lds), w2 = *reinterpret_cast<const u32x4*>(ones_lds + 16);
    const i32x8 ones = __builtin_bit_cast(i32x8, __builtin_shufflevector(w1, w2, 0, 1, 2, 3, 4, 5, 6, 7));
    asm("v_mfma_scale_f32_32x32x64_f8f6f4 %0, %1, %2, %0, %3, %3 op_sel_hi:[0,0,0]" : "+v"(lacc) : "v"(pa), "v"(ones), "v"(mxs));
}
__device__ __forceinline__ void qkt8(f32x16& p0, f32x16& p1, const char* Ks, int ka, const i32x8& q8, const f32x16& z, int mxs) {
    const u32x4 x0 = *reinterpret_cast<const u32x4*>(Ks + ka), x1 = *reinterpret_cast<const u32x4*>(Ks + (ka ^ 16));
    const u32x4 y0 = *reinterpret_cast<const u32x4*>(Ks + 2048 + ka), y1 = *reinterpret_cast<const u32x4*>(Ks + 2048 + (ka ^ 16));
    const i32x8 k0 = __builtin_bit_cast(i32x8, __builtin_shufflevector(x0, x1, 0, 1, 2, 3, 4, 5, 6, 7)), k1 = __builtin_bit_cast(i32x8, __builtin_shufflevector(y0, y1, 0, 1, 2, 3, 4, 5, 6, 7));
    p0 = __builtin_amdgcn_mfma_scale_f32_32x32x64_f8f6f4(k0, q8, z, 0, 0, 0, mxs, 0, 0x7C7C7C7C);
    p1 = __builtin_amdgcn_mfma_scale_f32_32x32x64_f8f6f4(k1, q8, z, 0, 0, 0, mxs, 0, 0x7C7C7C7C);
}
template <int VAR = 0> __device__ __forceinline__ void body(const unsigned char* __restrict__ Qb8, const unsigned char* __restrict__ Kh8, const unsigned char* __restrict__ V8, int seq, char* lds, f32x16 (&o)[4]) {
    constexpr int V8LD = NKEY;
    const int tid = threadIdx.x, wid = tid >> 6, lane = tid & 63, r32 = lane & 31, hi = lane >> 5;
    char* V_lds = lds; char* K_lds = lds + NRING * SHM_V;
    float* ws = (float*)(lds + NRING * SHM_V + NRING * SHM_K) + wid * 64; float* al_l = ws;
    float M = 0.f; const int mxs = 0x7F7F7F7F; f32x16 lacc = f32x16{};
    if (__builtin_amdgcn_readfirstlane(wid) >= 4) __builtin_amdgcn_s_setprio(1);
#pragma unroll
    for (int d = 0; d < 4; ++d) o[d] = f32x16{};
    i32x8 q8;
    { const unsigned char* qp = Qb8 + (size_t)(wid * QBLK + r32) * 64 + 32 * hi; const u32x4 x0 = *reinterpret_cast<const u32x4*>(qp), x1 = *reinterpret_cast<const u32x4*>(qp + 16);
      q8 = __builtin_bit_cast(i32x8, __builtin_shufflevector(x0, x1, 0, 1, 2, 3, 4, 5, 6, 7)); }
    const int vdv = tid >> 2, vch = tid & 3, vst = vdv * 64 + ((vch ^ ((vdv >> 2) & 3)) << 4);
    const int kr = (tid >> 2) & 63, kst = kr * 64 + ((vch ^ ((kr >> 2) & 3)) << 4);
    const int va = r32 * 64 + (((2 * hi) ^ ((r32 >> 2) & 3)) << 4);
    struct { u32x4 vs0, ks0; } sr_[2];
#define SLOAD(i, k0) do { sr_[i].vs0 = *reinterpret_cast<const u32x4*>(V8 + (size_t)vdv * V8LD + (k0) + vch * 16); sr_[i].ks0 = *reinterpret_cast<const u32x4*>(Kh8 + (size_t)((k0) + kr) * 64 + vch * 16); } while (0)
#define SWRITE(b, i) do { *(u32x4*)(V_lds + (b) * SHM_V + vst) = sr_[i].vs0; if (tid < 256) *(u32x4*)(K_lds + (b) * SHM_K + kst) = sr_[i].ks0; } while (0)
#define SWAIT() asm volatile("s_waitcnt vmcnt(2)" ::: "memory")
#define RESC(a) do { if (__any((a) < 1.f)) { if (hi == 0) al_l[r32] = (a); asm volatile("s_nop 7\n\ts_nop 7\n\ts_nop 7\n\ts_waitcnt lgkmcnt(0)" : "+v"(o[0]), "+v"(o[1]), "+v"(o[2]), "+v"(o[3]), "+v"(lacc) :: "memory"); \
    _Pragma("unroll") for (int r = 0; r < 16; ++r) { const float a_ = al_l[crow(r, hi)]; lacc[r] *= a_; _Pragma("unroll") for (int d = 0; d < 4; ++d) o[d][r] *= a_; } } } while (0)
    f32x16 pA0, pA1, pB0, pB1; float alA, alB; const int NT = seq / KVBLK;
    constexpr int SE = 0, SO = 1;
    SLOAD(SE, 0); SLOAD(SO, KVBLK);
    asm volatile("s_waitcnt vmcnt(2)" ::: "memory"); SWRITE(0, SE); __syncthreads();
#define QK_(P0, P1, KS, NM) do { if constexpr (VAR == 4 || VAR == 5) { _Pragma("unroll") for (int r_ = 0; r_ < 16; ++r_) { P0[r_] = zc[r_] + (float)r_; P1[r_] = zc[r_]; } } else qkt8(P0, P1, KS, va, q8, zc, mxs); } while (0)
#define PSM_(F, P0, P1, AL) do { if constexpr (VAR == 5) { AL = 1.f; } else partialSM<F>(P0, P1, M, AL, zc); } while (0)
#define FSM_(P0, P1) do { if constexpr (VAR == 5) { pa[0] = (int)__float_as_uint(P0[0]); } else finishSM(P0, P1, pa); } while (0)
#define PV_(VS) do { if constexpr (VAR == 3 || VAR == 5) { o[0][0] += __uint_as_float((unsigned)pa[0]) + __uint_as_float((unsigned)pa[7]); } else pv(o, lacc, VS, va, pa, mxs, ones_lds); } while (0)
    i32x8 pa = {0, 0, 0, 0, 0, 0, 0, 0};
    const char* ones_lds = (const char*)(ws + 32);
    if (lane < 8) ws[32 + lane] = __uint_as_float(0x38383838u);
    asm volatile("s_waitcnt lgkmcnt(0)" ::: "memory");
    f32x16 zc;
#pragma unroll
    for (int r = 0; r < 16; ++r) zc[r] = 4.f;
    QK_(pA0, pA1, K_lds, 4.f); PSM_(true, pA0, pA1, alA);
    SLOAD(SE, ((2 < NT) ? 2 : NT - 1) * KVBLK);
    SWAIT(); SWRITE(1, SO); __syncthreads();
    int rk = 1, rv = 0, rw = 2;
#define STEP_(j, PC0, PC1, PP0, PP1, ALC, SW, SL) do { \
        SBAR(); QK_(PC0, PC1, K_lds + rk * SHM_K, 4.f - M); FSM_(PP0, PP1); SBAR(); \
        SLOAD(SL, (((j) + 2 < NT) ? (j) + 2 : NT - 1) * KVBLK); SBAR(); \
        PV_(V_lds + rv * SHM_V); PSM_(false, PC0, PC1, ALC); \
        SWAIT(); SWRITE(rw, SW); RESC(ALC); __syncthreads(); \
        rv = rk; rk = rw; rw = (rw == NRING - 1) ? 0 : rw + 1; } while (0)
#define STEPC_(j, PC0, PC1, PP0, PP1, ALC, SW, SL, RK, RV, RW) do { \
        SBAR(); QK_(PC0, PC1, K_lds + (RK) * SHM_K, 4.f - M); FSM_(PP0, PP1); SBAR(); \
        SLOAD(SL, (((j) + 2 < NT) ? (j) + 2 : NT - 1) * KVBLK); SBAR(); \
        PV_(V_lds + (RV) * SHM_V); PSM_(false, PC0, PC1, ALC); \
        SWAIT(); SWRITE(RW, SW); RESC(ALC); __syncthreads(); } while (0)
    int j = 1;
#pragma nounroll
    for (; j + 6 < NT; j += 6) {
        STEPC_(j, pB0, pB1, pA0, pA1, alB, SE, SO, 1, 0, 2);
        STEPC_(j + 1, pA0, pA1, pB0, pB1, alA, SO, SE, 2, 1, 0);
        STEPC_(j + 2, pB0, pB1, pA0, pA1, alB, SE, SO, 0, 2, 1);
        STEPC_(j + 3, pA0, pA1, pB0, pB1, alA, SO, SE, 1, 0, 2);
        STEPC_(j + 4, pB0, pB1, pA0, pA1, alB, SE, SO, 2, 1, 0);
        STEPC_(j + 5, pA0, pA1, pB0, pB1, alA, SO, SE, 0, 2, 1);
    }
#undef STEPC_
#pragma nounroll
    for (; j + 1 < NT; j += 2) {
        STEP_(j, pB0, pB1, pA0, pA1, alB, SE, SO);
        STEP_(j + 1, pA0, pA1, pB0, pB1, alA, SO, SE);
    }
    SBAR(); QK_(pB0, pB1, K_lds + rk * SHM_K, 4.f - M);
    FSM_(pA0, pA1); SBAR();
    PV_(V_lds + rv * SHM_V); PSM_(false, pB0, pB1, alB);
    RESC(alB);
    FSM_(pB0, pB1); SBAR();
    PV_(V_lds + rk * SHM_V);
#undef STEP_
    asm volatile("s_nop 7\n\ts_nop 7\n\ts_nop 7" : "+v"(o[0]), "+v"(o[1]), "+v"(o[2]), "+v"(o[3]), "+v"(lacc) :: "memory");
#pragma unroll
    for (int r = 0; r < 16; ++r) { const float rl = __builtin_amdgcn_rcpf(lacc[r]);
#pragma unroll
        for (int d = 0; d < 4; ++d) o[d][r] *= rl; }
    __builtin_amdgcn_s_setprio(0);
    asm volatile("s_waitcnt vmcnt(0) lgkmcnt(0)" ::: "memory"); __syncthreads();
#undef SLOAD
#undef SWRITE
#undef SWAIT
#undef RESC
#undef QK_
#undef PSM_
#undef FSM_
#undef PV_
}
}

#define XB_TMO      128
#define XB_XCNT(j)  (256  + 64 * (j))
#define XB_XSUB(j)  (1280 + 64 * (j))
#define XB_XGEN(j)  (2304 + 64 * (j))
#define XB_TOP      3328
#define XB_TOPGEN   3392
#define XCD_BAR_WORDS 3456
#define XB_SPIN_CAP (1u << 18)
__device__ __forceinline__ unsigned xb_ld(unsigned* p)              { return __hip_atomic_load(p, __ATOMIC_RELAXED, __HIP_MEMORY_SCOPE_AGENT); }
__device__ __forceinline__ unsigned xb_add(unsigned* p, unsigned v) { return __hip_atomic_fetch_add(p, v, __ATOMIC_RELAXED, __HIP_MEMORY_SCOPE_AGENT); }
__device__ __forceinline__ unsigned xb_xcc_id() { return (unsigned)__builtin_amdgcn_s_getreg((3 << 11) | 20) & 0xFu; }
#define XB_SPIN(cond, bar) do { unsigned _sp = 0; while (cond) { __builtin_amdgcn_s_sleep(1); \
    if ((++_sp & 255u) == 0u) { if (xb_ld(&(bar)[XB_TMO])) break; if (_sp > XB_SPIN_CAP) { atomicAdd(&(bar)[XB_TMO], 1u); break; } } } } while (0)
struct XcdBarrier { unsigned* bar; unsigned x; volatile LAS unsigned* st; };
__device__ __forceinline__ XcdBarrier xcd_barrier_post(unsigned* bar, volatile LAS unsigned* st) {
    XcdBarrier b; b.bar = bar; b.x = xb_xcc_id(); b.st = st;
    if (threadIdx.x == 0) (void)xb_add(&bar[XB_XCNT(b.x)], 1u);
    return b;
}
__device__ __forceinline__ void xcd_barrier_complete(unsigned* bar, unsigned x, unsigned& nloc, unsigned& nx) {
    const unsigned G = gridDim.x * gridDim.y * gridDim.z;
    unsigned sum, cnt, mine, sp = 0u;
    for (;;) {
        sum = 0u; cnt = 0u; mine = 0u;
#pragma unroll
        for (unsigned j = 0; j < 16; ++j) { const unsigned c = xb_ld(&bar[XB_XCNT(j)]); sum += c; cnt += (c > 0u) ? 1u : 0u; mine = (j == x) ? c : mine; }
        if (sum == G) break;
        __builtin_amdgcn_s_sleep(1);
        if ((++sp & 255u) == 0u) { if (xb_ld(&bar[XB_TMO])) break; if (sp > XB_SPIN_CAP) { atomicAdd(&bar[XB_TMO], 1u); break; } }
    }
    nloc = mine > 0u ? mine : 1u; nx = cnt > 0u ? cnt : 1u;
}
__device__ __forceinline__ void xcd_barrier(const XcdBarrier& b) {
    asm volatile("s_waitcnt vmcnt(0)" ::: "memory");
    __syncthreads();
    if (threadIdx.x == 0) {
        unsigned* bar = b.bar;
        __builtin_amdgcn_s_waitcnt(0);
        unsigned nloc = b.st[0], nx = b.st[1];
        if (nloc == 0u) { xcd_barrier_complete(bar, b.x, nloc, nx); b.st[0] = nloc; b.st[1] = nx; }
        const unsigned mygen = b.st[2]; b.st[2] = mygen + 1u;
        const unsigned old = xb_add(&bar[XB_XSUB(b.x)], 1u);
        if (old + 1u == (mygen + 1u) * nloc) {
            __builtin_amdgcn_fence(__ATOMIC_RELEASE, "agent");
            asm volatile("s_waitcnt vmcnt(0)" ::: "memory");
            const unsigned og = xb_add(&bar[XB_TOP], 1u);
            if (og + 1u == (mygen + 1u) * nx) xb_add(&bar[XB_TOPGEN], 1u);
        }
        XB_SPIN(xb_ld(&bar[XB_TOPGEN]) <= mygen, bar);
        __builtin_amdgcn_fence(__ATOMIC_ACQUIRE, "agent");
        asm volatile("s_waitcnt vmcnt(0)" ::: "memory");
    }
    __syncthreads();
}

constexpr int RING_BYTES = 131072;
constexpr int MISC_OFF = RING_BYTES + 320;
constexpr int LDS_BYTES = 132096;
constexpr int NWAVES = 8;

__device__ __forceinline__ void transpose_item(const float* __restrict__ W, int K, int N, bf16_t* WT, int kb, int nb, int dst_row0, LAS float* scr, int lane) {
    const int k0 = 64 * kb, n0 = 32 * nb;
    {
        f32x4 t[8];
#pragma unroll
        for (int i = 0; i < 8; ++i) t[i] = *(const f32x4*)(W + (size_t)(k0 + 8 * i + (lane >> 3)) * N + n0 + 4 * (lane & 7));
#pragma unroll
        for (int i = 0; i < 8; ++i) { LAS float* d = scr + (8 * i + (lane >> 3)) * 33 + 4 * (lane & 7); d[0] = t[i].x; d[1] = t[i].y; d[2] = t[i].z; d[3] = t[i].w; }
    }
    LDS_WAIT(); asm volatile("" ::: "memory");
    const int c = lane & 7;
#pragma unroll
    for (int j = 0; j < 4; ++j) { const int n = (lane >> 3) + 8 * j; const LAS float* s = scr + (8 * c) * 33 + n;
        u32x4 o; o.x = cvtpk(s[0 * 33], s[1 * 33]); o.y = cvtpk(s[2 * 33], s[3 * 33]); o.z = cvtpk(s[4 * 33], s[5 * 33]); o.w = cvtpk(s[6 * 33], s[7 * 33]);
        *(u32x4*)(WT + (size_t)(dst_row0 + n) * K + k0 + 8 * c) = o; }
    LDS_WAIT(); asm volatile("" ::: "memory");
}
__device__ __forceinline__ void transpose_item_fp8(const float* __restrict__ W, int K, int N, unsigned char* WT8, int kb, int nb, int dst_row0, float wscale, LAS float* scr, int lane) {
    const int k0 = 64 * kb, n0 = 32 * nb;
    {
        f32x4 t[8];
#pragma unroll
        for (int i = 0; i < 8; ++i) t[i] = *(const f32x4*)(W + (size_t)(k0 + 8 * i + (lane >> 3)) * N + n0 + 4 * (lane & 7));
#pragma unroll
        for (int i = 0; i < 8; ++i) { LAS float* d = scr + (8 * i + (lane >> 3)) * 33 + 4 * (lane & 7); d[0] = t[i].x; d[1] = t[i].y; d[2] = t[i].z; d[3] = t[i].w; }
    }
    LDS_WAIT(); asm volatile("" ::: "memory");
    const int c = lane & 7;
#pragma unroll
    for (int j = 0; j < 4; ++j) { const int n = (lane >> 3) + 8 * j; const LAS float* sp = scr + (8 * c) * 33 + n;
        u32x2 o; o.x = cvt4_fp8s(sp[0 * 33] * wscale, sp[1 * 33] * wscale, sp[2 * 33] * wscale, sp[3 * 33] * wscale); o.y = cvt4_fp8s(sp[4 * 33] * wscale, sp[5 * 33] * wscale, sp[6 * 33] * wscale, sp[7 * 33] * wscale);
        *(u32x2*)(WT8 + (size_t)(dst_row0 + n) * K + k0 + 8 * c) = o; }
    LDS_WAIT(); asm volatile("" ::: "memory");
}
__device__ __forceinline__ void tr8_load(const float* __restrict__ src, int N, int lane, f32x4 (&t)[8]) {
#pragma unroll
    for (int i = 0; i < 8; ++i) t[i] = *(const f32x4*)(src + (size_t)(8 * i + (lane >> 3)) * N + 4 * (lane & 7));
}
__device__ __forceinline__ void tr8_store(const f32x4 (&t)[8], unsigned char* dst, int K, float wscale, LAS float* scr, int lane) {
#pragma unroll
    for (int i = 0; i < 8; ++i) { LAS float* d = scr + (8 * i + (lane >> 3)) * 33 + 4 * (lane & 7); d[0] = t[i].x; d[1] = t[i].y; d[2] = t[i].z; d[3] = t[i].w; }
    LDS_WAIT(); asm volatile("" ::: "memory");
    const int c = lane & 7;
#pragma unroll
    for (int j = 0; j < 4; ++j) { const int n = (lane >> 3) + 8 * j; const LAS float* sp = scr + (8 * c) * 33 + n;
        u32x2 o; o.x = cvt4_fp8s(sp[0 * 33] * wscale, sp[1 * 33] * wscale, sp[2 * 33] * wscale, sp[3 * 33] * wscale); o.y = cvt4_fp8s(sp[4 * 33] * wscale, sp[5 * 33] * wscale, sp[6 * 33] * wscale, sp[7 * 33] * wscale);
        *(u32x2*)(dst + (size_t)n * K + 8 * c) = o; }
    LDS_WAIT(); asm volatile("" ::: "memory");
}
__device__ __forceinline__ void tr16_store(const f32x4 (&t)[8], bf16_t* dst, int K, LAS float* scr, int lane) {
#pragma unroll
    for (int i = 0; i < 8; ++i) { LAS float* d = scr + (8 * i + (lane >> 3)) * 33 + 4 * (lane & 7); d[0] = t[i].x; d[1] = t[i].y; d[2] = t[i].z; d[3] = t[i].w; }
    LDS_WAIT(); asm volatile("" ::: "memory");
    const int c = lane & 7;
#pragma unroll
    for (int j = 0; j < 4; ++j) { const int n = (lane >> 3) + 8 * j; const LAS float* sp = scr + (8 * c) * 33 + n;
        u32x4 o; o.x = cvtpk(sp[0 * 33], sp[1 * 33]); o.y = cvtpk(sp[2 * 33], sp[3 * 33]); o.z = cvtpk(sp[4 * 33], sp[5 * 33]); o.w = cvtpk(sp[6 * 33], sp[7 * 33]);
        *(u32x4*)(dst + (size_t)n * K + 8 * c) = o; }
    LDS_WAIT(); asm volatile("" ::: "memory");
}
__device__ __forceinline__ void load_row16(const float* src, int lane, f32x4 (&v)[4]) {
#pragma unroll
    for (int j = 0; j < 4; ++j) v[j] = *(const f32x4*)(src + 4 * lane + 256 * j);
}
__device__ __forceinline__ void load_row16_bf(const bf16_t* src, int lane, f32x4 (&v)[4]) {
#pragma unroll
    for (int j = 0; j < 4; ++j) { const u32x2 w = *(const u32x2*)(src + 4 * lane + 256 * j); v[j] = (f32x4){bflo(w.x), bfhi(w.x), bflo(w.y), bfhi(w.y)}; }
}
__device__ __forceinline__ float row_rstd(const f32x4 (&v)[4]) {
    float s = 0.f;
#pragma unroll
    for (int j = 0; j < 4; ++j) s += (v[j].x * v[j].x + v[j].y * v[j].y) + (v[j].z * v[j].z + v[j].w * v[j].w);
    return rsqrtf(wave_sum(s) * (1.f / D) + EPS);
}
__device__ __forceinline__ void modulate_store(f32x4 (&v)[4], float rstd, const float* g, const float* sh, const float* sc, bf16_t* dst, int lane) {
#pragma unroll
    for (int j = 0; j < 4; ++j) { const int c = 4 * lane + 256 * j;
        const f32x4 gg = *(const f32x4*)(g + c), s1 = *(const f32x4*)(sc + c), s0 = *(const f32x4*)(sh + c);
        v[j] = v[j] * rstd * gg * (1.f + s1) + s0;
        *(u32x2*)(dst + c) = (u32x2){cvtpk(v[j].x, v[j].y), cvtpk(v[j].z, v[j].w)}; }
}

__device__ __forceinline__ void modulate_store2(f32x4 (&v)[4], float rstd, const float* g, const float* sh, const float* sc, bf16_t* dst, unsigned char* dst8, int lane) {
#pragma unroll
    for (int j = 0; j < 4; ++j) { const int c = 4 * lane + 256 * j;
        const f32x4 gg = *(const f32x4*)(g + c), s1 = *(const f32x4*)(sc + c), s0 = *(const f32x4*)(sh + c);
        v[j] = v[j] * rstd * gg * (1.f + s1) + s0;
        *(u32x2*)(dst + c) = (u32x2){cvtpk(v[j].x, v[j].y), cvtpk(v[j].z, v[j].w)};
        *(unsigned*)(dst8 + c) = cvt4_fp8s(v[j].x, v[j].y, v[j].z, v[j].w); }
}
__device__ __forceinline__ void modulate_store2r(f32x4 (&v)[4], float rstd, const f32x4 (&a)[4], const f32x4 (&b)[4], bf16_t* dst, unsigned char* dst8, int lane) {
#pragma unroll
    for (int j = 0; j < 4; ++j) { const int c = 4 * lane + 256 * j;
        v[j] = (v[j] * rstd) * a[j] + b[j];
        *(u32x2*)(dst + c) = (u32x2){cvtpk(v[j].x, v[j].y), cvtpk(v[j].z, v[j].w)};
        *(unsigned*)(dst8 + c) = cvt4_fp8s(v[j].x, v[j].y, v[j].z, v[j].w); }
}
#define LOAD_MOD_AB(a_, b_, g_, md_) do { _Pragma("unroll") for (int j = 0; j < 4; ++j) { const int c_ = 4 * lane + 256 * j; a_[j] = *(const f32x4*)((g_) + c_) * (1.f + *(const f32x4*)((md_) + 1024 + c_)); b_[j] = *(const f32x4*)((md_) + c_); } } while (0)
template <int HALF> __device__ __forceinline__ void pool_chunk(const bf16_t* __restrict__ pz, bf16_t* __restrict__ dp, int t0, int T) {
    constexpr int NE = 8 + 2 * HALF;
    u32x4 e[NE];
#pragma unroll
    for (int i = 0; i < NE; ++i) { const int r = t0 - HALF + i; e[i] = (r >= 0 && r < T) ? *(const u32x4*)(pz + (size_t)r * 512) : (u32x4){0u, 0u, 0u, 0u}; }
    asm volatile("" ::: "memory");
#define PE_LO(w_) ((f32x4){bflo((w_).x), bfhi((w_).x), bflo((w_).y), bfhi((w_).y)})
#define PE_HI(w_) ((f32x4){bflo((w_).z), bfhi((w_).z), bflo((w_).w), bfhi((w_).w)})
    f32x4 s0 = {0.f, 0.f, 0.f, 0.f}, s1 = {0.f, 0.f, 0.f, 0.f};
#pragma unroll
    for (int i = 0; i < 2 * HALF; ++i) { s0 += PE_LO(e[i]); s1 += PE_HI(e[i]); }
#pragma unroll
    for (int k = 0; k < 8; ++k) {
        const int t = t0 + k; const int lo_t = max(t - HALF, 0), hi_t = min(t + HALF, T);
        const float inv = 1.f / (float)(hi_t - lo_t);
        const f32x4 d0 = s0 * inv - PE_LO(e[k + HALF]), d1 = s1 * inv - PE_HI(e[k + HALF]);
        *(u32x4*)(dp + (size_t)t * 512) = (u32x4){cvtpk(d0.x, d0.y), cvtpk(d0.z, d0.w), cvtpk(d1.x, d1.y), cvtpk(d1.z, d1.w)};
        s0 += PE_LO(e[k + 2 * HALF]) - PE_LO(e[k]); s1 += PE_HI(e[k + 2 * HALF]) - PE_HI(e[k]);
    }
#undef PE_LO
#undef PE_HI
}
__device__ __forceinline__ void small_tile(const bf16_t* __restrict__ A, int lda, const bf16_t* __restrict__ Bt, int ldb, int wr, int wc, int r32, int hi, f32x16& acc0, f32x16& acc1) {
    acc0 = f32x16{}; acc1 = f32x16{};
    const bf16_t* ap = A + (size_t)(32 * wr + r32) * lda + 8 * hi;
    const bf16_t* b0p = Bt + (size_t)(64 * wc + r32) * ldb + 8 * hi;
    const bf16_t* b1p = b0p + (size_t)32 * ldb;
#pragma unroll
    for (int s = 0; s < 8; ++s) {
        const bf16x8 a = *reinterpret_cast<const bf16x8*>(ap + 16 * s), b0 = *reinterpret_cast<const bf16x8*>(b0p + 16 * s), b1 = *reinterpret_cast<const bf16x8*>(b1p + 16 * s);
        acc0 = __builtin_amdgcn_mfma_f32_32x32x16_bf16(a, b0, acc0, 0, 0, 0);
        acc1 = __builtin_amdgcn_mfma_f32_32x32x16_bf16(a, b1, acc1, 0, 0, 0);
    }
}

__device__ __forceinline__ void small_tile_ln(const bf16_t* __restrict__ A, int lda, const bf16_t* __restrict__ Bt, int ldb, int wr, int wc, int r32, int hi, const LAS float* RS, const LAS float* RM, f32x16& acc0, f32x16& acc1, float& c0) {
    acc0 = f32x16{}; acc1 = f32x16{}; c0 = 0.f;
    const bf16_t* ap = A + (size_t)(32 * wr + r32) * lda + 8 * hi;
    const bf16_t* b0p = Bt + (size_t)(64 * wc + r32) * ldb + 8 * hi;
    const bf16_t* b1p = b0p + (size_t)32 * ldb;
#pragma unroll
    for (int s = 0; s < 8; ++s) {
        const u32x4 aw = *reinterpret_cast<const u32x4*>(ap + 16 * s);
        const bf16x8 b0 = *reinterpret_cast<const bf16x8*>(b0p + 16 * s), b1 = *reinterpret_cast<const bf16x8*>(b1p + 16 * s);
        const f32x4 r0 = *(const LAS f32x4*)(RS + 16 * s + 8 * hi), r1 = *(const LAS f32x4*)(RS + 16 * s + 8 * hi + 4);
        const f32x4 m0 = *(const LAS f32x4*)(RM + 16 * s + 8 * hi), m1 = *(const LAS f32x4*)(RM + 16 * s + 8 * hi + 4);
        const f32x4 a0 = (f32x4){bflo(aw.x), bfhi(aw.x), bflo(aw.y), bfhi(aw.y)}, a1 = (f32x4){bflo(aw.z), bfhi(aw.z), bflo(aw.w), bfhi(aw.w)};
        const f32x4 cm = a0 * m0 + a1 * m1; c0 += (cm.x + cm.y) + (cm.z + cm.w);
        const f32x4 s0 = a0 * r0, s1 = a1 * r1;
        const bf16x8 as = __builtin_bit_cast(bf16x8, (u32x4){cvtpk(s0.x, s0.y), cvtpk(s0.z, s0.w), cvtpk(s1.x, s1.y), cvtpk(s1.z, s1.w)});
        acc0 = __builtin_amdgcn_mfma_f32_32x32x16_bf16(as, b0, acc0, 0, 0, 0);
        acc1 = __builtin_amdgcn_mfma_f32_32x32x16_bf16(as, b1, acc1, 0, 0, 0);
    }
}

__device__ __forceinline__ void small_tile_ln4(const bf16_t* __restrict__ A, int lda, const bf16_t* __restrict__ Bt, int ldb, int wr, int r32, int hi, const LAS float* RS, const LAS float* RM, f32x16 (&acc)[4], float& c0) {
#pragma unroll
    for (int j = 0; j < 4; ++j) acc[j] = f32x16{};
    c0 = 0.f;
    const bf16_t* ap = A + (size_t)(32 * wr + r32) * lda + 8 * hi;
    const bf16_t* bp = Bt + (size_t)r32 * ldb + 8 * hi;
#pragma unroll
    for (int s = 0; s < 8; ++s) {
        const u32x4 aw = *reinterpret_cast<const u32x4*>(ap + 16 * s);
        bf16x8 b[4];
#pragma unroll
        for (int j = 0; j < 4; ++j) b[j] = *reinterpret_cast<const bf16x8*>(bp + (size_t)(32 * j) * ldb + 16 * s);
        const f32x4 r0 = *(const LAS f32x4*)(RS + 16 * s + 8 * hi), r1 = *(const LAS f32x4*)(RS + 16 * s + 8 * hi + 4);
        const f32x4 m0 = *(const LAS f32x4*)(RM + 16 * s + 8 * hi), m1 = *(const LAS f32x4*)(RM + 16 * s + 8 * hi + 4);
        const f32x4 a0 = (f32x4){bflo(aw.x), bfhi(aw.x), bflo(aw.y), bfhi(aw.y)}, a1 = (f32x4){bflo(aw.z), bfhi(aw.z), bflo(aw.w), bfhi(aw.w)};
        const f32x4 cm = a0 * m0 + a1 * m1; c0 += (cm.x + cm.y) + (cm.z + cm.w);
        const f32x4 s0 = a0 * r0, s1 = a1 * r1;
        const bf16x8 as = __builtin_bit_cast(bf16x8, (u32x4){cvtpk(s0.x, s0.y), cvtpk(s0.z, s0.w), cvtpk(s1.x, s1.y), cvtpk(s1.z, s1.w)});
#pragma unroll
        for (int j = 0; j < 4; ++j) acc[j] = __builtin_amdgcn_mfma_f32_32x32x16_bf16(as, b[j], acc[j], 0, 0, 0);
    }
}

__device__ __forceinline__ void na_loadk(const bf16_t* __restrict__ NK, size_t kb, int h, int r32, int hi, bf16x8 (&kf)[8]) {
    const bf16_t* kp = NK + (kb + r32) * 512 + h * 64 + hi * 8;
#pragma unroll
    for (int d0 = 0; d0 < 4; ++d0) { kf[2 * d0] = *reinterpret_cast<const bf16x8*>(kp + d0 * 16); kf[2 * d0 + 1] = *reinterpret_cast<const bf16x8*>(kp + 32 * 512 + d0 * 16); }
}
__device__ __forceinline__ void na_loadv(const bf16_t* __restrict__ NVT, size_t kb, int h, int r32, int hi, bf16x8 (&vf)[8]) {
#pragma unroll
    for (int d0 = 0; d0 < 2; ++d0)
#pragma unroll
        for (int ks = 0; ks < 4; ++ks) vf[d0 * 4 + ks] = *reinterpret_cast<const bf16x8*>(NVT + (size_t)(h * 64 + 32 * d0 + r32) * MROWS + kb + 16 * ks + 8 * hi);
}
__device__ __forceinline__ void na_qk(const bf16x8 (&kf)[8], const bf16x8 (&qr)[4], f32x16& p0, f32x16& p1) {
    p0 = f32x16{}; p1 = f32x16{};
#pragma unroll
    for (int d0 = 0; d0 < 4; ++d0) {
        p0 = __builtin_amdgcn_mfma_f32_32x32x16_bf16(kf[2 * d0], qr[d0], p0, 0, 0, 0);
        p1 = __builtin_amdgcn_mfma_f32_32x32x16_bf16(kf[2 * d0 + 1], qr[d0], p1, 0, 0, 0);
    }
}
__device__ __forceinline__ void na_smpv(f32x16& p0, f32x16& p1, const bf16x8 (&vf)[8], int r32, int hi, const LAS float* lb, unsigned mlo, unsigned mhi,
                                        float& m_reg, float& l_reg, f32x16 (&o)[2], LAS float* al_l) {
    float pmax = -INFINITY;
    if (lb) {
#pragma unroll
        for (int r = 0; r < 16; ++r) { const int c = (r & 3) + 8 * (r >> 2);
            const float b0 = lb[c], b1 = lb[32 + c];
            p0[r] = ((mlo >> c) & 1u) ? fmaf(p0[r], 0.125f, b0) : -INFINITY; p1[r] = ((mhi >> c) & 1u) ? fmaf(p1[r], 0.125f, b1) : -INFINITY;
            pmax = fmaxf(pmax, fmaxf(p0[r], p1[r])); }
    } else {
#pragma unroll
        for (int r = 0; r < 16; ++r) { p0[r] *= 0.125f; p1[r] *= 0.125f; pmax = fmaxf(pmax, fmaxf(p0[r], p1[r])); }
    }
    { auto rr = __builtin_amdgcn_permlane32_swap(__float_as_uint(pmax), __float_as_uint(pmax), false, false); pmax = fmaxf(__uint_as_float(rr[0]), __uint_as_float(rr[1])); }
    const float mn = fmaxf(m_reg, pmax); const float alpha = __expf(m_reg - mn); m_reg = mn;
    float ps = 0.f;
#pragma unroll
    for (int r = 0; r < 16; ++r) { p0[r] = __expf(p0[r] - mn); p1[r] = __expf(p1[r] - mn); ps += p0[r] + p1[r]; }
    { auto rr = __builtin_amdgcn_permlane32_swap(__float_as_uint(ps), __float_as_uint(ps), false, false); ps = __uint_as_float(rr[0]) + __uint_as_float(rr[1]); }
    l_reg = l_reg * alpha + ps;
    bf16x8 pa0, pa1, pa2, pa3;
    PK4(p0, 0, pa0); PK4(p0, 8, pa1); PK4(p1, 0, pa2); PK4(p1, 8, pa3);
    if (__any(alpha < 1.f)) {
        if (hi == 0) al_l[r32] = alpha;
        LDS_WAIT();
#pragma unroll
        for (int r = 0; r < 16; ++r) { const float a = al_l[crow(r, hi)]; o[0][r] *= a; o[1][r] *= a; }
        LDS_WAIT();
    }
#pragma unroll
    for (int d0 = 0; d0 < 2; ++d0) {
        o[d0] = __builtin_amdgcn_mfma_f32_32x32x16_bf16(pa0, vf[d0 * 4 + 0], o[d0], 0, 0, 0);
        o[d0] = __builtin_amdgcn_mfma_f32_32x32x16_bf16(pa1, vf[d0 * 4 + 1], o[d0], 0, 0, 0);
        o[d0] = __builtin_amdgcn_mfma_f32_32x32x16_bf16(pa2, vf[d0 * 4 + 2], o[d0], 0, 0, 0);
        o[d0] = __builtin_amdgcn_mfma_f32_32x32x16_bf16(pa3, vf[d0 * 4 + 3], o[d0], 0, 0, 0);
    }
}

__device__ __forceinline__ void na_smpv_lds(f32x16& p0, f32x16& p1, int vb, int r32, int hi, const LAS float* lb, unsigned mlo, unsigned mhi,
                                            float& m_reg, float& l_reg, f32x16 (&o)[2], LAS float* al_l) {
    float pmax = -INFINITY;
    if (lb) {
#pragma unroll
        for (int r = 0; r < 16; ++r) { const int c = (r & 3) + 8 * (r >> 2);
            const float b0 = lb[c], b1 = lb[32 + c];
            p0[r] = ((mlo >> c) & 1u) ? fmaf(p0[r], 0.125f, b0) : -INFINITY; p1[r] = ((mhi >> c) & 1u) ? fmaf(p1[r], 0.125f, b1) : -INFINITY;
            pmax = fmaxf(pmax, fmaxf(p0[r], p1[r])); }
    } else {
#pragma unroll
        for (int r = 0; r < 16; ++r) { p0[r] *= 0.125f; p1[r] *= 0.125f; pmax = fmaxf(pmax, fmaxf(p0[r], p1[r])); }
    }
    { auto rr = __builtin_amdgcn_permlane32_swap(__float_as_uint(pmax), __float_as_uint(pmax), false, false); pmax = fmaxf(__uint_as_float(rr[0]), __uint_as_float(rr[1])); }
    const float mn = fmaxf(m_reg, pmax); const float alpha = __expf(m_reg - mn); m_reg = mn;
    float ps = 0.f;
#pragma unroll
    for (int r = 0; r < 16; ++r) { p0[r] = __expf(p0[r] - mn); p1[r] = __expf(p1[r] - mn); ps += p0[r] + p1[r]; }
    { auto rr = __builtin_amdgcn_permlane32_swap(__float_as_uint(ps), __float_as_uint(ps), false, false); ps = __uint_as_float(rr[0]) + __uint_as_float(rr[1]); }
    l_reg = l_reg * alpha + ps;
    bf16x8 pa0, pa1, pa2, pa3;
    PK4(p0, 0, pa0); PK4(p0, 8, pa1); PK4(p1, 0, pa2); PK4(p1, 8, pa3);
    if (__any(alpha < 1.f)) {
        if (hi == 0) al_l[r32] = alpha;
        LDS_WAIT();
#pragma unroll
        for (int r = 0; r < 16; ++r) { const float a = al_l[crow(r, hi)]; o[0][r] *= a; o[1][r] *= a; }
        LDS_WAIT();
    }
    dattn::pv_one<0>(o[0], vb, pa0, pa1, pa2, pa3); dattn::pv_one<1>(o[1], vb, pa0, pa1, pa2, pa3);
}

__device__ __forceinline__ void na_smpv_fp8(f32x16& p0, f32x16& p1, const char* Vs, int va, int r32, int hi, const LAS float* lb, unsigned mlo, unsigned mhi,
                                            float& M, f32x16& lacc, f32x16 (&o)[2], LAS float* al_l, int mxs, f32x16& zc, bool first_tile) {
    float pmax = -INFINITY;
    if (lb) {
#pragma unroll
        for (int r = 0; r < 16; ++r) { const int c = (r & 3) + 8 * (r >> 2);
            const float b0 = lb[c], b1 = lb[32 + c];
            p0[r] = ((mlo >> c) & 1u) ? p0[r] + b0 : -INFINITY; p1[r] = ((mhi >> c) & 1u) ? p1[r] + b1 : -INFINITY;
            pmax = fmaxf(pmax, fmaxf(p0[r], p1[r])); }
    } else {
#pragma unroll
        for (int r = 0; r < 16; ++r) pmax = fmaxf(pmax, fmaxf(p0[r], p1[r]));
    }
    { auto rr = __builtin_amdgcn_permlane32_swap(__float_as_uint(pmax), __float_as_uint(pmax), false, false); pmax = fmaxf(__uint_as_float(rr[0]), __uint_as_float(rr[1])); }
    float alpha = 1.f;
    if (first_tile || !__builtin_expect(__all(pmax <= dattn8::THR2 + 4.f), 1)) {
        const float delta = first_tile ? pmax - 4.f : fmaxf(pmax - 4.f, 0.f);
        M += delta; if (!first_tile) alpha = __builtin_amdgcn_exp2f(-delta);
#pragma unroll
        for (int r = 0; r < 16; ++r) { p0[r] -= delta; p1[r] -= delta; zc[r] -= delta; }
    }
#pragma unroll
    for (int r = 0; r < 16; ++r) { p0[r] = __builtin_amdgcn_exp2f(p0[r]); p1[r] = __builtin_amdgcn_exp2f(p1[r]); }
    i32x8 pa;
#pragma unroll
    for (int g = 0; g < 4; ++g) { pa[g] = (int)cvt4_fp8n(p0[4 * g], p0[4 * g + 1], p0[4 * g + 2], p0[4 * g + 3]); pa[4 + g] = (int)cvt4_fp8n(p1[4 * g], p1[4 * g + 1], p1[4 * g + 2], p1[4 * g + 3]); }
    if (__any(alpha < 1.f)) {
        if (hi == 0) al_l[r32] = alpha;
        asm volatile("s_nop 7\n\ts_nop 7\n\ts_nop 7\n\ts_waitcnt lgkmcnt(0)" : "+v"(o[0]), "+v"(o[1]), "+v"(lacc) :: "memory");
#pragma unroll
        for (int r = 0; r < 16; ++r) { const float a = al_l[crow(r, hi)]; o[0][r] *= a; o[1][r] *= a; lacc[r] *= a; }
        LDS_WAIT();
    }
#pragma unroll
    for (int d0 = 0; d0 < 2; ++d0) {
        const u32x4 x0 = *reinterpret_cast<const u32x4*>(Vs + d0 * 2048 + va), x1 = *reinterpret_cast<const u32x4*>(Vs + d0 * 2048 + (va ^ 16));
        const i32x8 bv = __builtin_bit_cast(i32x8, __builtin_shufflevector(x0, x1, 0, 1, 2, 3, 4, 5, 6, 7));
        asm("s_nop 1\n\tv_mfma_scale_f32_32x32x64_f8f6f4 %0, %1, %2, %0, %3, %3 op_sel_hi:[0,0,0]" : "+v"(o[d0]) : "v"(pa), "v"(bv), "v"(mxs));
    }
    const u32x4 w1 = *(const LAS u32x4*)(al_l + 32), w2 = *(const LAS u32x4*)(al_l + 36);
    const i32x8 ones = __builtin_bit_cast(i32x8, __builtin_shufflevector(w1, w2, 0, 1, 2, 3, 4, 5, 6, 7));
    asm("s_nop 1\n\tv_mfma_scale_f32_32x32x64_f8f6f4 %0, %1, %2, %0, %3, %3 op_sel_hi:[0,0,0]" : "+v"(lacc) : "v"(pa), "v"(ones), "v"(mxs));
}

__device__ __forceinline__ void topk_list(LAS unsigned* sh, const float* __restrict__ aff, int N, int Ksel, int rowbase, int e, int slotbase, int* IDXROW, float* GATE, int* SEL) {
    LAS unsigned* hist = sh; LAS unsigned* wtot = sh + 256; LAS unsigned* ctl = sh + 272;
    const int tid = threadIdx.x, lane = tid & 63, wid = tid >> 6, base = tid * 16;
    unsigned k[16];
    if (base < N) {
#pragma unroll
        for (int j = 0; j < 4; ++j) { const f32x4 v = *(const f32x4*)(aff + base + 4 * j); k[4 * j] = __float_as_uint(v.x); k[4 * j + 1] = __float_as_uint(v.y); k[4 * j + 2] = __float_as_uint(v.z); k[4 * j + 3] = __float_as_uint(v.w); }
    } else {
#pragma unroll
        for (int j = 0; j < 16; ++j) k[j] = 0u;
    }
    if (tid == 0) { ctl[0] = 0u; ctl[1] = (unsigned)Ksel; ctl[2] = 255u; ctl[3] = 0u; }
    for (int pass = 0; pass < 4; ++pass) {
        const int shift = 24 - 8 * pass;
        if (tid < 256) hist[tid] = 0u;
        __syncthreads();
        const unsigned prefix = ctl[0], rem = ctl[1];
        bool generic = true;
        if (pass == 0) {
            unsigned bmn = 255u, bmx = 0u;
            if (base < N) {
#pragma unroll
                for (int j = 0; j < 16; ++j) { const unsigned b = k[j] >> 24; bmn = b < bmn ? b : bmn; bmx = b > bmx ? b : bmx; }
            }
#pragma unroll
            for (int off = 1; off < 64; off <<= 1) { const unsigned a = __shfl_xor(bmn, off), c = __shfl_xor(bmx, off); bmn = a < bmn ? a : bmn; bmx = c > bmx ? c : bmx; }
            if (lane == 0) { __hip_atomic_fetch_min(&ctl[2], bmn, __ATOMIC_RELAXED, __HIP_MEMORY_SCOPE_WORKGROUP); __hip_atomic_fetch_max(&ctl[3], bmx, __ATOMIC_RELAXED, __HIP_MEMORY_SCOPE_WORKGROUP); }
            __syncthreads();
            const unsigned blo = ctl[2], bhi = ctl[3];
            if (bhi - blo < 8u) {
                generic = false;
                for (unsigned v = blo; v <= bhi; ++v) {
                    unsigned c = 0u;
                    if (base < N) {
#pragma unroll
                        for (int j = 0; j < 16; ++j) c += ((k[j] >> 24) == v) ? 1u : 0u;
                    }
#pragma unroll
                    for (int off = 1; off < 64; off <<= 1) c += __shfl_xor(c, off);
                    if (lane == 0 && c) __hip_atomic_fetch_add(&hist[v], c, __ATOMIC_RELAXED, __HIP_MEMORY_SCOPE_WORKGROUP);
                }
            }
        }
        if (generic && base < N) {
#pragma unroll
            for (int j = 0; j < 16; ++j) { const bool match = (pass == 0) ? true : ((k[j] >> ((shift + 8) & 31)) == prefix); if (match) __hip_atomic_fetch_add(&hist[(k[j] >> shift) & 255u], 1u, __ATOMIC_RELAXED, __HIP_MEMORY_SCOPE_WORKGROUP); }
        }
        __syncthreads();
        if (wid == 0) {
            const unsigned c0 = hist[4 * lane], c1 = hist[4 * lane + 1], c2 = hist[4 * lane + 2], c3 = hist[4 * lane + 3];
            const unsigned s = c0 + c1 + c2 + c3; unsigned S = s;
#pragma unroll
            for (int off = 1; off < 64; off <<= 1) { const unsigned t = __shfl_down(S, off); if (lane + off < 64) S += t; }
            const unsigned above = S - s;
            if (above < rem && rem <= S) {
                unsigned a = above; int digit;
                if (a + c3 >= rem) digit = 3; else { a += c3; if (a + c2 >= rem) digit = 2; else { a += c2; if (a + c1 >= rem) digit = 1; else { a += c1; digit = 0; } } }
                ctl[0] = (prefix << 8) | (unsigned)(4 * lane + digit); ctl[1] = rem - a;
            }
        }
        __syncthreads();
    }
    const unsigned T = ctl[0], rem = ctl[1];
    unsigned g = 0, q = 0;
    if (base < N) {
#pragma unroll
        for (int j = 0; j < 16; ++j) { g += (k[j] > T) ? 1u : 0u; q += (k[j] == T) ? 1u : 0u; }
    }
    const unsigned packed = g | (q << 16); unsigned incl = packed;
#pragma unroll
    for (int off = 1; off < 64; off <<= 1) { const unsigned t = __shfl_up(incl, off); if (lane >= off) incl += t; }
    if (lane == 63) wtot[wid] = incl;
    __syncthreads();
    unsigned woff = 0;
    for (int w = 0; w < wid; ++w) woff += wtot[w];
    const unsigned excl = incl - packed + woff;
    unsigned Gb = excl & 0xffffu, Eb = excl >> 16;
    if (base < N) {
        int sel[16];
#pragma unroll
        for (int j = 0; j < 16; ++j) {
            const bool gt = k[j] > T, eq = k[j] == T; const bool selq = gt || (eq && Eb < rem);
            const unsigned slot = Gb + (Eb < rem ? Eb : rem);
            const int row = rowbase + base + j;
            sel[j] = selq ? (int)(slotbase + slot) : -1;
            if (selq) { IDXROW[e * ESLOT + slotbase + slot] = row; GATE[e * ESLOT + slotbase + slot] = __uint_as_float(k[j]); }
            Gb += gt ? 1u : 0u; Eb += eq ? 1u : 0u;
        }
        int* sp = SEL + (size_t)e * MROWS + rowbase + base;
#pragma unroll
        for (int j = 0; j < 4; ++j) *(i32x4_t*)(sp + 4 * j) = (i32x4_t){sel[4 * j], sel[4 * j + 1], sel[4 * j + 2], sel[4 * j + 3]};
    }
    __syncthreads();
}

#define ws (args.ws)
#define ctl ((unsigned*)(ws + WS_CTL))
#define SMALL ((float*)(ws + WS_SMALL))
#define MOD (SMALL + SM_MOD)
#define ROPE (SMALL + SM_ROPE)
#define LAM (SMALL + SM_LAM)
#define SEL ((int*)(ws + WS_SEL))
#define RWBG ((u32x4*)(ws + WS_SMALL + 512 * 1024))
#define AFFL ((float*)(ws + WS_AFFL))
#define AFFC ((float*)(ws + WS_AFFC))
#define IDXROW ((int*)(ws + WS_IDX))
#define GATE ((float*)(ws + WS_GATE))
#define WINT ((bf16_t*)(ws + WS_WINT))
#define WBRT ((bf16_t*)(ws + WS_WBRT))
#define WOUTT ((bf16_t*)(ws + WS_WOUTT))
#define POOLT ((bf16_t*)(ws + WS_POOLT))
#define SGUW ((bf16_t*)(ws + WS_SGUW))
#define X ((bf16_t*)(ws + WS_X))
#define HX ((bf16_t*)(ws + WS_HX))
#define HX8 ((unsigned char*)(ws + WS_HX8))
#define WINT8 ((unsigned char*)(ws + WS_WINT8))
#define DP ((bf16_t*)(ws + WS_DP))
#define SVT ((bf16_t*)(ws + WS_SVT))
#define QD ((bf16_t*)(ws + WS_QD))
#define KD ((bf16_t*)(ws + WS_KD))
#define VD ((bf16_t*)(ws + WS_VD))
#define NQ ((bf16_t*)(ws + WS_NQ))
#define NK ((bf16_t*)(ws + WS_NK))
#define NV ((bf16_t*)(ws + WS_NV))
#define MACC ((float*)(ws + WS_MACC))
#define MB ((bf16_t*)(ws + WS_MB))
#define PZ ((bf16_t*)(ws + WS_PZ))
#define O0 ((float*)(ws + WS_O0))
#define SVTR ((bf16_t*)(ws + WS_SVTR))
#define SVST ((float*)(ws + WS_SVST))
#define SU ((bf16_t*)(ws + WS_SU))
#define SV ((bf16_t*)(ws + WS_SV))
#define NVT ((bf16_t*)(ws + WS_NVT))
#define V8T ((unsigned char*)(ws + WS_NVT))
#define BR ((bf16_t*)(ws + WS_BR))
#define GZ ((bf16_t*)(ws + WS_GZ))
#define W13T ((bf16_t*)(ws + WS_W13T))
#define W2T ((bf16_t*)(ws + WS_W2T))
#define XS ((bf16_t*)(ws + WS_XS))
#define HID ((bf16_t*)(ws + WS_HID))
#define Y ((unsigned char*)(ws + WS_Y))

#define PH_IDS() int tid_ = threadIdx.x; asm volatile("" : "+v"(tid_)); const int tid = tid_, lane = tid & 63, wave = __builtin_amdgcn_readfirstlane(tid >> 6); const int gw = vcu * NWAVES + wave, gt = vcu * 512 + tid; (void)gw; (void)gt; (void)lane
#ifndef PHMASK
#define PHMASK 0x1ffffffu
#endif
#define IN(k) (((PHMASK >> (k)) & 1u) && lo <= (k) && (k) < hi_ph)
#define SEAM(k) do { if (IN((k) + 1)) { if (MK_PER_PHASE) { } else xcd_barrier(bar); } } while (0)


#ifndef PROBE_MASK
#define PROBE_MASK 0u
#endif
#ifndef PROBE_SUB
#define PROBE_SUB 0u
#endif
#if ((PROBE_MASK) >> 0) & 1u
#define PH_LOOP_0 _Pragma("nounroll") for (int rep_ = 0; rep_ < 2; ++rep_)
#else
#define PH_LOOP_0
#endif
#if ((PROBE_MASK) >> 1) & 1u
#define PH_LOOP_1 _Pragma("nounroll") for (int rep_ = 0; rep_ < 2; ++rep_)
#else
#define PH_LOOP_1
#endif
#if ((PROBE_MASK) >> 2) & 1u
#define PH_LOOP_2 _Pragma("nounroll") for (int rep_ = 0; rep_ < 2; ++rep_)
#else
#define PH_LOOP_2
#endif
#if ((PROBE_MASK) >> 3) & 1u
#define PH_LOOP_3 _Pragma("nounroll") for (int rep_ = 0; rep_ < 2; ++rep_)
#else
#define PH_LOOP_3
#endif
#if ((PROBE_MASK) >> 4) & 1u
#define PH_LOOP_4 _Pragma("nounroll") for (int rep_ = 0; rep_ < 2; ++rep_)
#else
#define PH_LOOP_4
#endif
#if ((PROBE_MASK) >> 5) & 1u
#define PH_LOOP_5 _Pragma("nounroll") for (int rep_ = 0; rep_ < 2; ++rep_)
#else
#define PH_LOOP_5
#endif
#if ((PROBE_MASK) >> 6) & 1u
#define PH_LOOP_6 _Pragma("nounroll") for (int rep_ = 0; rep_ < 2; ++rep_)
#else
#define PH_LOOP_6
#endif
#if ((PROBE_MASK) >> 7) & 1u
#define PH_LOOP_7 _Pragma("nounroll") for (int rep_ = 0; rep_ < 2; ++rep_)
#else
#define PH_LOOP_7
#endif
#if ((PROBE_MASK) >> 8) & 1u
#define PH_LOOP_8 _Pragma("nounroll") for (int rep_ = 0; rep_ < 2; ++rep_)
#else
#define PH_LOOP_8
#endif
#if ((PROBE_MASK) >> 9) & 1u
#define PH_LOOP_9 _Pragma("nounroll") for (int rep_ = 0; rep_ < 2; ++rep_)
#else
#define PH_LOOP_9
#endif
#if ((PROBE_MASK) >> 10) & 1u
#define PH_LOOP_10 _Pragma("nounroll") for (int rep_ = 0; rep_ < 2; ++rep_)
#else
#define PH_LOOP_10
#endif
#if ((PROBE_MASK) >> 11) & 1u
#define PH_LOOP_11 _Pragma("nounroll") for (int rep_ = 0; rep_ < 2; ++rep_)
#else
#define PH_LOOP_11
#endif
#if ((PROBE_SUB) >> 0) & 1u
#define SUB_LOOP_0 _Pragma("nounroll") for (int reps_ = 0; reps_ < 2; ++reps_)
#else
#define SUB_LOOP_0
#endif
#if ((PROBE_SUB) >> 1) & 1u
#define SUB_LOOP_1 _Pragma("nounroll") for (int reps_ = 0; reps_ < 2; ++reps_)
#else
#define SUB_LOOP_1
#endif
#if ((PROBE_SUB) >> 2) & 1u
#define SUB_LOOP_2 _Pragma("nounroll") for (int reps_ = 0; reps_ < 2; ++reps_)
#else
#define SUB_LOOP_2
#endif
template <int l>
__device__ __forceinline__ void run_layer(const Args& args, LAS unsigned char* L, unsigned char* lds, const int G, const int bx, const int vcu, const int lo, const int hi_ph, const XcdBarrier& bar) {
    const int NGW = G * NWAVES, NGT = G * 512; (void)NGT;
        const int pb = 1 + 12 * l;
        const bool first = (l == 0);
        const float* MODL = MOD + l * 3 * 6144;
        const int nrows = first ? MROWS : MLAT;

        PH_LOOP_0 if (IN(pb + 0)) {
            PH_IDS();
            if (first) {
                f32x4 vn[4]; f32x4 ma[4], mb[4]; int mrp = -1;
#define P0_SRC(row_) (((row_) >= MLAT) ? args.in[I_CTX] + (size_t)((row_) - MLAT) * 1024 : args.in[I_X] + (size_t)(row_) * 1024)
                if (gw < MROWS) load_row16(P0_SRC(gw), lane, vn);
                for (int row = gw; row < MROWS; row += NGW) {
                    const int mr = row >= MLAT ? 2 : (row >> 13);
                    if (mr != mrp) { const float* md = MODL + mr * 6144; LOAD_MOD_AB(ma, mb, args.in[I_N1G] + l * 1024, md); mrp = mr; }
                    f32x4 v[4];
#pragma unroll
                    for (int j = 0; j < 4; ++j) v[j] = vn[j];
                    if (row + NGW < MROWS) load_row16(P0_SRC(row + NGW), lane, vn);
                    const float rstd = row_rstd(v);
                    modulate_store2r(v, rstd, ma, mb, HX + (size_t)row * 1024, HX8 + (size_t)row * 1024, lane);
                }
#undef P0_SRC
                SEAM(pb + 0);
            }
        }
        PH_LOOP_1 if (IN(pb + 1)) {
            PH_IDS();
            { WinOrder S{G, bx, first ? 34 : 8, 1, 0, (const char*)HX8, (const char*)WINT8 + (size_t)l * INC * 1024, (size_t)256 * 1024};
              EpiWin E{QD, KD, SVTR, NQ, NK, (bf16_t*)SVST, SU, SV, GZ, PZ, ROPE, 1.f / 32.f, V8T};
              pg8::gemm_phase<EpiWin, WinOrder, true, true>(L, 512, S, E); }
            { WinOrder S{G, bx, first ? 34 : 8, 0, 1, (const char*)HX, (const char*)(WINT + (size_t)l * INC * 1024), (size_t)256 * 1024 * 2};
              EpiWin E{QD, KD, SVTR, NQ, NK, (bf16_t*)SVST, SU, SV, GZ, PZ, ROPE, 1.f, V8T};
              pg8::gemm_phase<EpiWin, WinOrder, true>(L, 1024, S, E); }
            SEAM(pb + 1);
        }
        PH_LOOP_3 if (IN(pb + 3)) {
            PH_IDS();
            const float lam = LAM[l]; const float lam_init = 0.8f - 0.6f * expf(-0.3f * (float)l);
            const int r32 = lane & 31, hi = lane >> 5;
#ifndef SKIP_P
            {
            for (int i = gt; i < (nrows / 8) * 64; i += NGT) {
                const int wv_ = i >> 6, ln_ = i & 63, g = wv_ & 3, rc = (wv_ >> 2) * 4 + (ln_ >> 4), c8 = g * 16 + (ln_ & 15); const int row0 = rc * 8;
                int rb, t0, T; if (row0 < MLAT) { rb = row0 & ~8191; t0 = row0 & 8191; T = SEQ; } else { rb = MLAT + ((row0 - MLAT) & ~255); t0 = (row0 - MLAT) & 255; T = CTX; }
                const bf16_t* pz = PZ + (size_t)rb * 512 + c8 * 8; bf16_t* dp = DP + (size_t)rb * 512 + c8 * 8;
                if (g == 0) pool_chunk<1>(pz, dp, t0, T); else if (g == 1) pool_chunk<2>(pz, dp, t0, T); else if (g == 2) pool_chunk<4>(pz, dp, t0, T); else pool_chunk<8>(pz, dp, t0, T);
            }
            }
#endif
#ifndef SKIP_A
            SUB_LOOP_0 {
                const int nun = 256 + (first ? 8 : 0);
                const int nit = 2 * ((nun - vcu + G - 1) / G);
#pragma nounroll
                for (int it = 0; it < nit; ++it) {
                    const int u = vcu + (it >> 1) * G, mm = it & 1;
                    const bool isctx = u >= 256; const int bh = isctx ? u - 256 : u >> 5, qb = isctx ? 0 : (u & 31);
                    const int b = bh >> 2, h = bh & 3; const int q0 = isctx ? 0 : CTX + qb * 256; const int seq = isctx ? CTX : NKEY;
                    const size_t hb = (size_t)((b * 4 + h) * 2 + mm) * NKEY * 64;
                    f32x16 o[4];
#ifndef ATTN_BF16
                    dattn8::body<0>((const unsigned char*)QD + hb + (size_t)q0 * 64, (const unsigned char*)KD + hb, V8T + (size_t)(b * 4 + h) * 128 * NKEY, seq, (char*)lds, o);
#else
                    dattn::body<0>(QD + hb + (size_t)q0 * 64, KD + hb, VD + (size_t)(b * 4 + h) * NKEY * 128, seq, (char*)lds, o);
#endif
                    int zo = 0; asm volatile("" : "+v"(zo));
                    float* o0p = O0 + (size_t)(vcu % 256) * 32768 + tid + zo;
                    if (mm == 0) {
#pragma unroll
                        for (int d = 0; d < 4; ++d)
#pragma unroll
                            for (int r = 0; r < 16; ++r) o0p[(d * 16 + r) * 512] = o[d][r];
                    } else {
                        float ssq[16];
#pragma unroll
                        for (int r = 0; r < 16; ++r) { float s = 0.f;
#pragma unroll
                            for (int d = 0; d < 4; ++d) { const float a = o0p[(d * 16 + r) * 512] - lam * o[d][r]; o[d][r] = a; s += a * a; }
                            ssq[r] = s; }
#pragma unroll
                        for (int off = 1; off < 32; off <<= 1)
#pragma unroll
                            for (int r = 0; r < 16; ++r) ssq[r] += __shfl_xor(ssq[r], off);
                        const size_t rowb = (isctx ? (size_t)MLAT + b * CTX : (size_t)b * SEQ + qb * 256) + wave * 32;
                        bf16_t* brp = BR + (size_t)1 * MROWS * 512 + rowb * 512 + h * 128 + r32 + zo;
                        const float* gp = args.in[I_SUBLN] + l * 128 + r32 + zo;
                        const float g0 = gp[0], g1 = gp[32], g2 = gp[64], g3 = gp[96];
#pragma unroll
                        for (int r = 0; r < 16; ++r) { const float sc = rsqrtf(ssq[r] * (1.f / 128.f) + EPS) * (1.f - lam_init);
                            bf16_t* rp = brp + (size_t)crow(r, hi) * 512;
                            rp[0] = (bf16_t)(cvtpk(o[0][r] * sc * g0, 0.f) & 0xffffu); rp[32] = (bf16_t)(cvtpk(o[1][r] * sc * g1, 0.f) & 0xffffu);
                            rp[64] = (bf16_t)(cvtpk(o[2][r] * sc * g2, 0.f) & 0xffffu); rp[96] = (bf16_t)(cvtpk(o[3][r] * sc * g3, 0.f) & 0xffffu); }
                    }
                }
            }
#ifdef PROBE_ATTN_VAR
            {
                PH_IDS();
                const int nit = 2 * ((256 - vcu + G - 1) / G);
#pragma nounroll
                for (int it = 0; it < nit; ++it) {
                    const int u = vcu + (it >> 1) * G, mm = it & 1; const int bh = u >> 5, qb = u & 31, b = bh >> 2, h = bh & 3;
                    const size_t hb = (size_t)((b * 4 + h) * 2 + mm) * NKEY * 64;
                    f32x16 o[4];
                    dattn8::body<PROBE_ATTN_VAR>((const unsigned char*)QD + hb + (size_t)(CTX + qb * 256) * 64, (const unsigned char*)KD + hb, V8T + (size_t)(b * 4 + h) * 128 * NKEY, NKEY, (char*)lds, o);
                    int zo = 0; asm volatile("" : "+v"(zo));
                    float* o0p = O0 + (size_t)(vcu % 256) * 32768 + tid + zo;
#pragma unroll
                    for (int d = 0; d < 4; ++d)
#pragma unroll
                        for (int r = 0; r < 16; ++r) o0p[(d * 16 + r) * 512] = o[d][r];
                }
            }
#endif
#endif
            __syncthreads();
#ifndef SKIP_B
            SUB_LOOP_1 {
                PH_IDS(); const int r32 = lane & 31, hi = lane >> 5; const int hl = wave & 3, half = wave >> 2;
                LAS float* wsc = (LAS float*)(L + 65536) + wave * 384;   LAS float* al_l = wsc; LAS float* sb = wsc + 32 + 48;
                char* Lg = (char*)lds;
                if (lane < 8) al_l[32 + lane] = __uint_as_float(0x38383838u);
                constexpr int NSTG = 32768, NKS = 16384;
                const unsigned char* NQ8 = (const unsigned char*)NQ; const unsigned char* NK8 = (const unsigned char*)NK; const unsigned char* NV8T = V8T + NV8T_OFF;
                const int mxs = 0x7F7F7F7F;
                const int nun = 512 + (first ? 16 : 0);
                for (int u = vcu; u < nun; u += G) {
                    const bool isctx = u >= 512; int b, hg, row0, gr = 0;
                    if (!isctx) { hg = u & 1; const int gri = u >> 1; b = gri >> 7; gr = gri & 127; row0 = b * SEQ + gr * 64; }
                    else { const int uc = u - 512; hg = uc & 1; const int cc = uc >> 1; b = cc >> 2; row0 = MLAT + b * CTX + (cc & 3) * 64; }
                    const int h = 4 * hg + hl;
                    i32x8 q8;
                    { const unsigned char* qp = NQ8 + (size_t)(row0 + 32 * half + r32) * 512 + h * 64 + 32 * hi; const u32x4 x0 = *reinterpret_cast<const u32x4*>(qp), x1 = *reinterpret_cast<const u32x4*>(qp + 16);
                      q8 = __builtin_bit_cast(i32x8, __builtin_shufflevector(x0, x1, 0, 1, 2, 3, 4, 5, 6, 7)); }
                    float M = 0.f; f32x16 lacc = f32x16{}; f32x16 o[2]; o[0] = f32x16{}; o[1] = f32x16{}; f32x16 zc;
#pragma unroll
                    for (int r = 0; r < 16; ++r) zc[r] = 4.f;
                    int r0 = 0; unsigned mlo = 0u, mhi = 0u; int lboff = 0;
                    if (!isctx) {
                        r0 = min(max(gr - 4, 0), 120);
                        const int cq = 32 * half + r32, cs = min(max(cq - 8, 0), 48);
                        const unsigned long long mk = (0xffffull << cs) >> (4 * hi); mlo = (unsigned)mk; mhi = (unsigned)(mk >> 32);
                        lboff = 15 - cq + 4 * hi;
                        { float tb[4];
#pragma unroll
                          for (int q = 0; q < 4; ++q) { const int i = lane + 64 * q, ii = i / 31, dc = i % 31; tb[q] = (i < 248) ? args.in[I_RPB][((size_t)(l * 8 + h) * 15 + (r0 + ii - gr + 7)) * 31 + dc] : 0.f; }
#pragma unroll
                          for (int q = 0; q < 4; ++q) { const int i = lane + 64 * q; if (i < 248) sb[i] = 1.4426950408889634f * tb[q]; } }
                        LDS_WAIT();
                    }
                    const int toff = isctx ? 8 : 0, nt = 12 - toff;
                    const size_t kloc = (size_t)b * SEQ + (size_t)r0 * 64, kctx = (size_t)MLAT + b * CTX;
#define NA_KB(ti) ((ti) < 8 ? kloc + (size_t)(ti) * 64 : kctx + (size_t)((ti) - 8) * 64)
                    u32x4 sk[2], sv[2];
#define NA_SLOAD(ti) do { const size_t kb_ = NA_KB(ti); _Pragma("unroll") for (int q = 0; q < 2; ++q) { const int idx = tid + 512 * q; \
                        sk[q] = *(const u32x4*)(NK8 + (kb_ + (idx >> 4)) * 512 + hg * 256 + (idx & 15) * 16); sv[q] = *(const u32x4*)(NV8T + (size_t)(hg * 256 + (idx >> 2)) * MROWS + kb_ + (idx & 3) * 16); } } while (0)
#define NA_SWRITE(buf) do { _Pragma("unroll") for (int q = 0; q < 2; ++q) { const int idx = tid + 512 * q; \
                        { const int row = idx >> 4, ch = idx & 15; *(u32x4*)(Lg + (buf) * NSTG + (ch >> 2) * 4096 + row * 64 + (((ch & 3) ^ ((row >> 2) & 3)) << 4)) = sk[q]; } \
                        { const int vr = idx >> 2, c = idx & 3; *(u32x4*)(Lg + (buf) * NSTG + NKS + (vr >> 6) * 4096 + (vr & 63) * 64 + ((c ^ (((vr & 63) >> 2) & 3)) << 4)) = sv[q]; } } } while (0)
                    const int ka = r32 * 64 + (((2 * hi) ^ ((r32 >> 2) & 3)) << 4);
                    NA_SLOAD(toff); NA_SWRITE(0); __syncthreads();
#pragma nounroll
                    for (int t = 0; t < nt; ++t) {
                        const int ti = toff + t, buf = t & 1;
                        if (t + 1 < nt) NA_SLOAD(ti + 1);
                        const char* Ks = Lg + buf * NSTG + hl * 4096;
                        f32x16 p0, p1;
                        { const u32x4 x0 = *reinterpret_cast<const u32x4*>(Ks + ka), x1 = *reinterpret_cast<const u32x4*>(Ks + (ka ^ 16));
                          const u32x4 y0 = *reinterpret_cast<const u32x4*>(Ks + 2048 + ka), y1 = *reinterpret_cast<const u32x4*>(Ks + 2048 + (ka ^ 16));
                          const i32x8 k0 = __builtin_bit_cast(i32x8, __builtin_shufflevector(x0, x1, 0, 1, 2, 3, 4, 5, 6, 7)), k1 = __builtin_bit_cast(i32x8, __builtin_shufflevector(y0, y1, 0, 1, 2, 3, 4, 5, 6, 7));
                          p0 = __builtin_amdgcn_mfma_scale_f32_32x32x64_f8f6f4(k0, q8, zc, 0, 0, 0, mxs, 0, 0x7C7C7C7C);
                          p1 = __builtin_amdgcn_mfma_scale_f32_32x32x64_f8f6f4(k1, q8, zc, 0, 0, 0, mxs, 0, 0x7C7C7C7C); }
                        na_smpv_fp8(p0, p1, Lg + buf * NSTG + NKS + hl * 4096, ka, r32, hi, (ti < 8) ? (const LAS float*)(sb + ti * 31 + lboff) : (const LAS float*)nullptr, mlo, mhi, M, lacc, o, al_l, mxs, zc, t == 0);
                        if (t + 1 < nt) NA_SWRITE(buf ^ 1);
                        __syncthreads();
                    }
#undef NA_KB
#undef NA_SLOAD
#undef NA_SWRITE
                    asm volatile("s_nop 7\n\ts_nop 7\n\ts_nop 7" : "+v"(o[0]), "+v"(o[1]), "+v"(lacc) :: "memory");
#pragma unroll
                    for (int r = 0; r < 16; ++r) { const float rl = __builtin_amdgcn_rcpf(lacc[r]); const size_t row = (size_t)row0 + 32 * half + crow(r, hi);
#pragma unroll
                        for (int d0 = 0; d0 < 2; ++d0) BR[(size_t)3 * MROWS * 512 + row * 512 + h * 64 + 32 * d0 + r32] = (bf16_t)(cvtpk(o[d0][r] * rl, 0.f) & 0xffffu); }
                }
            }
#endif
#ifndef SKIP_C
            SUB_LOOP_2 {
                PH_IDS(); const int r32 = lane & 31, hi = lane >> 5;
                const int hw = wave >> 2, wr = wave & 3, th = tid & 255; const int ntl = nrows / 128, nun = ntl * 4;
                LAS float* RS = (LAS float*)L + hw * 512; LAS float* RM = RS + 128; LAS float* C0 = RS + 256 + wr * 32;
                for (int u0 = vcu; u0 < nun; u0 += 2 * G) {
                    const int u = u0 + hw * G; const bool live = u < nun; const int tl = live ? (u >> 2) : 0, g = u & 3;
                    __syncthreads();
                    if (th < 128) {
                        const float* sp = SVST + ((size_t)tl * 128 + th) * 16; float s1 = 0.f, s2 = 0.f;
#pragma unroll
                        for (int k = 0; k < 4; ++k) { const f32x4 w = *(const f32x4*)(sp + 4 * k); s1 += w.x + w.z; s2 += w.y + w.w; }
                        const float mean = s1 * (1.f / 512.f); const float var = fmaxf(s2 * (1.f / 512.f) - mean * mean, 0.f); const float rstd = rsqrtf(var + EPS);
                        RS[th] = rstd; RM[th] = rstd * mean;
                    }
                    __syncthreads();
                    if (live) {
                        f32x16 acc[4]; float c0;
                        small_tile_ln4(SGUW + (size_t)(l * 4 + g) * 16384, 128, SVTR + (size_t)(g * 128) * MROWS + (size_t)tl * 128, MROWS, wr, r32, hi, RS, RM, acc, c0);
                        c0 += __shfl_xor(c0, 32);
                        if (hi == 0) C0[r32] = c0;
                        LDS_WAIT(); asm volatile("" ::: "memory");
                        float gam[4];
#pragma unroll
                        for (int j = 0; j < 4; ++j) gam[j] = args.in[I_SGUG][l * 512 + g * 128 + 32 * j + r32];
                        bf16_t suv[16][4]; float bpv[16];
#pragma unroll
                        for (int r = 0; r < 16; ++r) { const int p = 32 * wr + crow(r, hi); const size_t row = (size_t)tl * 128 + p; bpv[r] = args.in[I_SGUB][l * 512 + g * 128 + p];
#pragma unroll
                            for (int j = 0; j < 4; ++j) suv[r][j] = SU[row * 512 + g * 128 + 32 * j + r32]; }
                        asm volatile("" ::: "memory");
#pragma unroll
                        for (int r = 0; r < 16; ++r) { const int p = 32 * wr + crow(r, hi); const size_t row = (size_t)tl * 128 + p; const float c0p = C0[crow(r, hi)], bp = bpv[r];
#pragma unroll
                            for (int j = 0; j < 4; ++j) { const int col = g * 128 + 32 * j + r32;
                                const float y = bf2f(suv[r][j]) * (gam[j] * (acc[j][r] - c0p) + bp);
                                BR[(size_t)2 * MROWS * 512 + row * 512 + col] = (bf16_t)(cvtpk(y, 0.f) & 0xffffu); } }
                    }
                }
            }
#endif
            SEAM(pb + 3);
        }
        PH_LOOP_4 if (IN(pb + 4)) {
            PH_IDS();
            if (first) {
                const int r32 = lane & 31, hi = lane >> 5, br = wave & 3;
                LAS float* PT = (LAS float*)L + wave * 1024;
                for (int tb = 0; tb < 512; tb += 2 * G) {
                    const int tile = tb + (wave >> 2) * G + vcu; const bool live = tile < 512; const int rt = live ? (tile >> 5) : 0, ct = tile & 31;
                    if (live) {
                        f32x16 acc = f32x16{};
                        const bf16_t* ap = (br == 0 ? DP : BR + (size_t)br * MROWS * 512) + (size_t)(MLAT + 32 * rt + r32) * 512 + 8 * hi;
                        const bf16_t* bp = WBRT + ((size_t)(l * 4 + br) * 1024 + 32 * ct + r32) * 512 + 8 * hi;
#pragma nounroll
                        for (int s0 = 0; s0 < 32; s0 += 16) {
                            bf16x8 fa[16], fb[16];
#pragma unroll
                            for (int q = 0; q < 16; ++q) { fa[q] = *reinterpret_cast<const bf16x8*>(ap + 16 * (s0 + q)); fb[q] = *reinterpret_cast<const bf16x8*>(bp + 16 * (s0 + q)); }
#pragma unroll
                            for (int q = 0; q < 16; ++q) acc = __builtin_amdgcn_mfma_f32_32x32x16_bf16(fa[q], fb[q], acc, 0, 0, 0);
                        }
#pragma unroll
                        for (int r = 0; r < 16; ++r) { const size_t row = (size_t)MLAT + 32 * rt + crow(r, hi); const unsigned char* gp = (const unsigned char*)GZ + ((size_t)(br * 32 + ct) * MROWS + row) * 32 + r32;
                            PT[r * 64 + lane] = acc[r] * ((float)gp[0] * (1.f / 255.f)); }
                    }
                    __syncthreads();
                    if (live && br == 0) {
#pragma unroll
                        for (int r = 0; r < 16; ++r) { const size_t row = (size_t)MLAT + 32 * rt + crow(r, hi);
                            const float v = ((PT[r * 64 + lane] + PT[1024 + r * 64 + lane]) + PT[2048 + r * 64 + lane]) + PT[3072 + r * 64 + lane];
                            MB[row * 1024 + 32 * ct + r32] = (bf16_t)(cvtpk(v, 0.f) & 0xffffu); }
                    }
                    __syncthreads();
                }
            }
            MergeOrder S{G, bx, 64, (const char*)BR, (const char*)(WBRT + (size_t)l * 4 * 1024 * 512), (const char*)DP};
            EpiMerge E{GZ, MB};
            pg8::gemm_phase<EpiMerge, MergeOrder, true>(L, 512, S, E);
            SEAM(pb + 4);
        }
        PH_LOOP_5 if (IN(pb + 5)) {
            PH_IDS();
            if (first) {
                const int r32 = lane & 31, hi = lane >> 5, kq = wave & 3;
                LAS float* PT = (LAS float*)L + wave * 1024;
                for (int tb = 0; tb < 512; tb += 2 * G) {
                    const int tile = tb + (wave >> 2) * G + vcu; const bool live = tile < 512; const int rt = live ? (tile >> 5) : 0, ct = tile & 31;
                    if (live) {
                        f32x16 acc = f32x16{};
                        const bf16_t* ap = MB + (size_t)(MLAT + 32 * rt + r32) * 1024 + 256 * kq + 8 * hi;
                        const bf16_t* bp = WOUTT + ((size_t)l * 1024 + 32 * ct + r32) * 1024 + 256 * kq + 8 * hi;
                        bf16x8 fa[16], fb[16];
#pragma unroll
                        for (int q = 0; q < 16; ++q) { fa[q] = *reinterpret_cast<const bf16x8*>(ap + 16 * q); fb[q] = *reinterpret_cast<const bf16x8*>(bp + 16 * q); }
#pragma unroll
                        for (int q = 0; q < 16; ++q) acc = __builtin_amdgcn_mfma_f32_32x32x16_bf16(fa[q], fb[q], acc, 0, 0, 0);
#pragma unroll
                        for (int r = 0; r < 16; ++r) PT[r * 64 + lane] = acc[r];
                    }
                    __syncthreads();
                    if (live && kq == 0) {
                        const float g1 = MODL[2 * 6144 + 2048 + 32 * ct + r32];
#pragma unroll
                        for (int r = 0; r < 16; ++r) { const size_t rc = (size_t)32 * rt + crow(r, hi);
                            const float v = ((PT[r * 64 + lane] + PT[1024 + r * 64 + lane]) + PT[2048 + r * 64 + lane]) + PT[3072 + r * 64 + lane];
                            X[(MLAT + rc) * 1024 + 32 * ct + r32] = (bf16_t)(cvtpk(args.in[I_CTX][rc * 1024 + 32 * ct + r32] + g1 * v, 0.f) & 0xffffu); }
                    }
                    __syncthreads();
                }
            }
            WoutOrder S{G, bx, 64, (const char*)MB, (const char*)(WOUTT + (size_t)l * 1024 * 1024)};
            EpiWout E{args.in[I_X], args.in[I_CTX], X, MODL, first ? 1 : 0};
            pg8::gemm_phase<EpiWout, WoutOrder, false>(L, 1024, S, E);
            SEAM(pb + 5);
        }
        PH_LOOP_6 if (IN(pb + 6)) {
            PH_IDS();
            const int r32 = lane & 31, hi = lane >> 5;
            LAS u32x4* RWB = (LAS u32x4*)L;
            LAS float* PSQ = (LAS float*)(L + 102400);
            LAS f32x4* PA = (LAS f32x4*)(L + 66048);
            const int ntask = nrows / 32;
            u32x4 xs[8];
#define P6_LOAD(task_) do { const bf16_t* xr_ = X + (size_t)((task_) * 32 + r32) * 1024 + 128 * wave + 8 * hi; _Pragma("unroll") for (int ss = 0; ss < 8; ++ss) xs[ss] = *(const u32x4*)(xr_ + 16 * ss); } while (0)
            if (vcu < ntask) P6_LOAD(vcu);
            LAS float* MA = (LAS float*)(L + 104448);
            {
                float tg[6], ts[6], tb[6];
#pragma unroll
                for (int q = 0; q < 6; ++q) { const int i = tid + 512 * q, mr = i >> 10, c = i & 1023; tg[q] = args.in[I_N2G][l * 1024 + c]; ts[q] = MODL[mr * 6144 + 4096 + c]; tb[q] = MODL[mr * 6144 + 3072 + c]; }
#pragma unroll
                for (int q = 0; q < 6; ++q) { const int i = tid + 512 * q; MA[i] = tg[q] * (1.f + ts[q]); MA[3072 + i] = tb[q]; }
            }
            {
                const u32x4* src = RWBG + (size_t)l * 4096; u32x4 t8[8];
#pragma unroll
                for (int i = 0; i < 8; ++i) t8[i] = src[tid + 512 * i];
#pragma unroll
                for (int i = 0; i < 8; ++i) RWB[tid + 512 * i] = t8[i];
            }
            __syncthreads();
            for (int task = vcu; task < ntask; task += G) {
                const int row0 = task * 32; const bool isctx = row0 >= MLAT; const LAS float* mA = MA + (isctx ? 2 : (row0 >> 13)) * 1024;
                const bf16_t* xr = X + (size_t)(row0 + r32) * 1024; unsigned char* hxr = HX8 + (size_t)(row0 + r32) * 1024;
                float qs = 0.f;
#pragma unroll
                for (int ss = 0; ss < 8; ++ss) { const u32x4 w = xs[ss]; const float e0 = bflo(w.x), e1 = bfhi(w.x), e2 = bflo(w.y), e3 = bfhi(w.y), e4 = bflo(w.z), e5 = bfhi(w.z), e6 = bflo(w.w), e7 = bfhi(w.w);
                    qs += ((e0 * e0 + e1 * e1) + (e2 * e2 + e3 * e3)) + ((e4 * e4 + e5 * e5) + (e6 * e6 + e7 * e7)); }
                qs += __shfl_xor(qs, 32);
                if (hi == 0) PSQ[wave * 32 + r32] = qs;
                __syncthreads();
                float tot = 0.f;
#pragma unroll
                for (int w = 0; w < 8; ++w) tot += PSQ[w * 32 + r32];
                const float rs = rsqrtf(tot * (1.f / D) + EPS);
                f32x16 acc = f32x16{};
#pragma unroll
                for (int ss = 0; ss < 8; ++ss) {
                    const int c0 = 128 * wave + 16 * ss + 8 * hi;
                    const u32x4 xw = xs[ss]; const f32x4 x0 = (f32x4){bflo(xw.x), bfhi(xw.x), bflo(xw.y), bfhi(xw.y)}, x1 = (f32x4){bflo(xw.z), bfhi(xw.z), bflo(xw.w), bfhi(xw.w)};
                    const f32x4 a0 = *(const LAS f32x4*)(mA + c0), a1 = *(const LAS f32x4*)(mA + c0 + 4), b0 = *(const LAS f32x4*)(mA + 3072 + c0), b1 = *(const LAS f32x4*)(mA + 3072 + c0 + 4);
                    const f32x4 h0 = (x0 * rs) * a0 + b0, h1 = (x1 * rs) * a1 + b1;
                    const u32x4 hw = (u32x4){cvtpk(h0.x, h0.y), cvtpk(h0.z, h0.w), cvtpk(h1.x, h1.y), cvtpk(h1.z, h1.w)};
                    *(u32x2*)(hxr + c0) = (u32x2){cvt4_fp8s(h0.x, h0.y, h0.z, h0.w), cvt4_fp8s(h1.x, h1.y, h1.z, h1.w)};
                    const u32x4 lw = (u32x4){cvtpk(h0.x - bflo(hw.x), h0.y - bfhi(hw.x)), cvtpk(h0.z - bflo(hw.y), h0.w - bfhi(hw.y)), cvtpk(h1.x - bflo(hw.z), h1.y - bfhi(hw.z)), cvtpk(h1.z - bflo(hw.w), h1.w - bfhi(hw.w))};
                    const bf16x8 bfr = __builtin_bit_cast(bf16x8, RWB[(8 * wave + ss) * 64 + lane]);
                    acc = __builtin_amdgcn_mfma_f32_32x32x16_bf16(__builtin_bit_cast(bf16x8, hw), bfr, acc, 0, 0, 0);
                    acc = __builtin_amdgcn_mfma_f32_32x32x16_bf16(__builtin_bit_cast(bf16x8, lw), bfr, acc, 0, 0, 0);
                }
#pragma unroll
                for (int q = 0; q < 4; ++q) PA[(wave * 4 + q) * 64 + lane] = (f32x4){acc[4 * q], acc[4 * q + 1], acc[4 * q + 2], acc[4 * q + 3]};
                if (task + G < ntask) P6_LOAD(task + G);
                __syncthreads();
                if (wave < 4) {
                    const int q = wave; f32x4 sacc = PA[q * 64 + lane];
#pragma unroll
                    for (int w = 1; w < 8; ++w) sacc += PA[(w * 4 + q) * 64 + lane];
                    float t[4] = {sacc.x, sacc.y, sacc.z, sacc.w};
#pragma unroll
                    for (int i = 0; i < 4; ++i) { t[i] += __shfl_xor(t[i], 16);
                        float mx = t[i];
#pragma unroll
                        for (int o = 1; o < 16; o <<= 1) mx = fmaxf(mx, __shfl_xor(mx, o));
                        const float p = __expf(t[i] - mx); float den = p;
#pragma unroll
                        for (int o = 1; o < 16; o <<= 1) den += __shfl_xor(den, o);
                        t[i] = p / den; }
                    if (r32 < 16) {
                        float* ap = isctx ? AFFC + (size_t)(((row0 - MLAT) >> 8) * 16 + r32) * CTX + ((row0 - MLAT) & 255) : AFFL + (size_t)((row0 >> 13) * 16 + r32) * SEQ + (row0 & 8191);
                        *(f32x4*)(ap + 8 * q + 4 * hi) = (f32x4){t[0], t[1], t[2], t[3]};
                    }
                }
                __syncthreads();
            }
#undef P6_LOAD
            SEAM(pb + 6);
        }
        PH_LOOP_7 if (IN(pb + 7)) {
            PH_IDS();
            const int nlist = first ? 64 : 32;
            for (int li = vcu; li < nlist; li += G) {
                if (li < 32) { const int b = li >> 4, e = li & 15; topk_list((LAS unsigned*)L, AFFL + (size_t)li * SEQ, SEQ, CAP, b * SEQ, e, b * CAP, IDXROW, GATE, SEL); }
                else { const int lc = li - 32, b = lc >> 4, e = lc & 15; topk_list((LAS unsigned*)L, AFFC + (size_t)lc * CTX, CTX, CAPC, MLAT + b * CTX, e, 2 * CAP + b * CAPC, IDXROW, GATE, SEL); }
            }
            LAS float* scr = (LAS float*)(L + wave * 16384);
            const int nA = (nlist < G ? nlist : 0) * 24, wv = vcu * NWAVES + wave;
            const int it0 = (vcu < nlist && nA) ? wv : nA + (wv - (nA ? nlist * NWAVES : 0)), its = (vcu < nlist && nA) ? nlist * NWAVES : (G - (nA ? nlist : 0)) * NWAVES, ite = (vcu < nlist && nA) ? nA : 16 * 1536;
#define WC_DESC(it_, src_, dst_) do { const int e_ = (it_) / 1536; int r_ = (it_) % 1536; const size_t wo_ = ((size_t)l * 16 + e_) * 1024 * 1024; \
                if (r_ < 512) { const int kb_ = r_ / 32, n0_ = 32 * (r_ % 32); src_ = args.in[I_W1] + wo_ + (size_t)(64 * kb_) * 1024 + n0_; dst_ = (unsigned char*)W13T + (size_t)e_ * 2048 * 1024 + (size_t)(256 * (n0_ >> 7) + (n0_ & 127)) * 1024 + 64 * kb_; } \
                else if (r_ < 1024) { r_ -= 512; const int kb_ = r_ / 32, n0_ = 32 * (r_ % 32); src_ = args.in[I_W3] + wo_ + (size_t)(64 * kb_) * 1024 + n0_; dst_ = (unsigned char*)W13T + (size_t)e_ * 2048 * 1024 + (size_t)(256 * (n0_ >> 7) + 128 + (n0_ & 127)) * 1024 + 64 * kb_; } \
                else { r_ -= 1024; const int kb_ = r_ / 32, n0_ = 32 * (r_ % 32); src_ = args.in[I_W2] + wo_ + (size_t)(64 * kb_) * 1024 + n0_; dst_ = (unsigned char*)W2T + (size_t)e_ * 1024 * 1024 + (size_t)n0_ * 1024 + 64 * kb_; } } while (0)
            {
                f32x4 tA[8], tB[8]; const float* sA = nullptr; const float* sB = nullptr; unsigned char* dA = nullptr; unsigned char* dB = nullptr;
                int it = it0;
                if (it < ite) { WC_DESC(it, sA, dA); tr8_load(sA, 1024, lane, tA); }
#pragma nounroll
                while (it < ite) {
                    if (it + its < ite) { WC_DESC(it + its, sB, dB); tr8_load(sB, 1024, lane, tB); }
                    tr8_store(tA, dA, 1024, 32.f, scr, lane);
                    it += its; if (it >= ite) break;
                    if (it + its < ite) { WC_DESC(it + its, sA, dA); tr8_load(sA, 1024, lane, tA); }
                    tr8_store(tB, dB, 1024, 32.f, scr, lane);
                    it += its;
                }
            }
#undef WC_DESC
            SEAM(pb + 7);
        }
        const int nslot = first ? 2 * CAP + 2 * CAPC : 2 * CAP;
        PH_LOOP_9 if (IN(pb + 9)) {
            PH_IDS();
            MoeOrder S{G, bx, first ? 9 : 8, 8, (const char*)HX8, (const char*)W13T, (size_t)256 * 1024, IDXROW, MROWS - 1};
            EpiW13 E{(unsigned char*)HID};
            pg8::gemm_phase<EpiW13, MoeOrder, true, true, true>(L, 512, S, E);
            SEAM(pb + 9);
        }
        PH_LOOP_10 if (IN(pb + 10)) {
            PH_IDS();
            MoeOrder S{G, bx, first ? 9 : 8, 4, (const char*)HID, (const char*)W2T, (size_t)256 * 1024, nullptr, 0};
            EpiW2 E{Y, GATE};
            pg8::gemm_phase<EpiW2, MoeOrder, true, true>(L, 512, S, E);
            SEAM(pb + 10);
        }
        PH_LOOP_11 if (IN(pb + 11)) {
            PH_IDS();
            f32x4 g2v[4], ma[4], mb[4]; int mrp = -1;
            u32x2 xnA[4], xnB[4]; int svnA = -1, svnB = -1;
#define P11_PREF(row_, xn_, svn_) do { if ((row_) < nrows) { const bf16_t* xp_ = X + (size_t)(row_) * 1024; _Pragma("unroll") for (int j = 0; j < 4; ++j) xn_[j] = *(const u32x2*)(xp_ + 4 * lane + 256 * j); svn_ = (lane < 16) ? SEL[(size_t)lane * MROWS + (row_)] : -1; } else svn_ = -1; } while (0)
#define P11_ISSUE(sv_, msk_, yw_, have_) do { msk_ = __ballot(sv_ >= 0); _Pragma("unroll") for (int k = 0; k < 4; ++k) { have_[k] = msk_ != 0ull; \
                if (have_[k]) { const int e = __ffsll((unsigned long long)msk_) - 1; msk_ &= msk_ - 1ull; const int sl = __builtin_amdgcn_readlane(sv_, e); const unsigned char* yp = Y + (size_t)(e * ESLOT + sl) * 1024; \
                    _Pragma("unroll") for (int j = 0; j < 4; ++j) yw_[k][j] = *(const unsigned*)(yp + 4 * lane + 256 * j); } } } while (0)
#define P11_MOD(mr_) do { if ((mr_) != mrp) { const float* md = MODL + (mr_) * 6144; mrp = (mr_);        \
                _Pragma("unroll") for (int j = 0; j < 4; ++j) g2v[j] = *(const f32x4*)(md + 5120 + 4 * lane + 256 * j) * (1.f / 128.f); \
                if (first) { const float* md1 = MOD + (3 + (mr_)) * 6144; LOAD_MOD_AB(ma, mb, args.in[I_N1G] + 1024, md1); } \
                else { _Pragma("unroll") for (int j = 0; j < 4; ++j) ma[j] = *(const f32x4*)(args.in[I_FING] + 4 * lane + 256 * j); } } } while (0)
#define P11_FINISH(row_, v_, sv_, msk_, yw_, have_) do { \
                f32x4 ys[4]; _Pragma("unroll") for (int j = 0; j < 4; ++j) ys[j] = (f32x4){0.f, 0.f, 0.f, 0.f}; \
                _Pragma("unroll") for (int k = 0; k < 4; ++k) if (have_[k]) { _Pragma("unroll") for (int j = 0; j < 4; ++j) { const unsigned w = yw_[k][j]; const auto lo = __builtin_amdgcn_cvt_pk_f32_fp8((int)w, false), hi2 = __builtin_amdgcn_cvt_pk_f32_fp8((int)w, true); ys[j] += (f32x4){lo[0], lo[1], hi2[0], hi2[1]}; } } \
                while (msk_) { const int e = __ffsll((unsigned long long)msk_) - 1; msk_ &= msk_ - 1ull; const int sl = __builtin_amdgcn_readlane(sv_, e); const unsigned char* yp = Y + (size_t)(e * ESLOT + sl) * 1024; \
                    _Pragma("unroll") for (int j = 0; j < 4; ++j) { const unsigned w = *(const unsigned*)(yp + 4 * lane + 256 * j); const auto lo = __builtin_amdgcn_cvt_pk_f32_fp8((int)w, false), hi2 = __builtin_amdgcn_cvt_pk_f32_fp8((int)w, true); ys[j] += (f32x4){lo[0], lo[1], hi2[0], hi2[1]}; } } \
                P11_MOD(((row_) >= MLAT) ? 2 : ((row_) >> 13)); \
                _Pragma("unroll") for (int j = 0; j < 4; ++j) v_[j] += g2v[j] * ys[j]; \
                const float rstd = row_rstd(v_); \
                if (first) { _Pragma("unroll") for (int j = 0; j < 4; ++j) *(u32x2*)(X + (size_t)(row_) * 1024 + 4 * lane + 256 * j) = (u32x2){cvtpk(v_[j].x, v_[j].y), cvtpk(v_[j].z, v_[j].w)}; \
                    modulate_store2r(v_, rstd, ma, mb, HX + (size_t)(row_) * 1024, HX8 + (size_t)(row_) * 1024, lane); } \
                else { _Pragma("unroll") for (int j = 0; j < 4; ++j) { const int c = 4 * lane + 256 * j; *(f32x4*)(args.out + (size_t)(row_) * 1024 + c) = v_[j] * rstd * ma[j]; } } } while (0)
            P11_PREF(gw, xnA, svnA); P11_PREF(gw + NGW, xnB, svnB);
            for (int row = gw; row < nrows; row += 2 * NGW) {
                const int rowB = row + NGW; const bool liveB = rowB < nrows;
                f32x4 vA[4], vB[4];
#pragma unroll
                for (int j = 0; j < 4; ++j) { vA[j] = (f32x4){bflo(xnA[j].x), bfhi(xnA[j].x), bflo(xnA[j].y), bfhi(xnA[j].y)}; vB[j] = (f32x4){bflo(xnB[j].x), bfhi(xnB[j].x), bflo(xnB[j].y), bfhi(xnB[j].y)}; }
                const int svA = svnA, svB = svnB;
                unsigned long long mskA, mskB; unsigned ywA[4][4], ywB[4][4]; bool haveA[4], haveB[4];
                P11_ISSUE(svA, mskA, ywA, haveA); P11_ISSUE(svB, mskB, ywB, haveB);
                P11_PREF(row + 2 * NGW, xnA, svnA); P11_PREF(rowB + 2 * NGW, xnB, svnB);
                P11_FINISH(row, vA, svA, mskA, ywA, haveA);
                if (liveB) P11_FINISH(rowB, vB, svB, mskB, ywB, haveB);
            }
#undef P11_ISSUE
#undef P11_MOD
#undef P11_FINISH
#undef P11_PREF
            SEAM(pb + 11);
        }
    }

__global__ void __launch_bounds__(NWAVES * 64, 2) mega_fwd(Args args) {
    extern __shared__ __attribute__((aligned(16))) unsigned char lds[];
    LAS unsigned char* L = (LAS unsigned char*)lds;
    volatile LAS unsigned* MISC = (volatile LAS unsigned*)(L + MISC_OFF);
    const int tid = threadIdx.x, lane = tid & 63, wave = __builtin_amdgcn_readfirstlane(tid >> 6);
    const int G = gridDim.x; const int bx = blockIdx.x; const int vcu = (G % 8 == 0) ? (bx % 8) * (G / 8) + bx / 8 : bx;
    const int NGW = G * NWAVES, NGT = G * 512;
    for (int u = tid; u < (LDS_BYTES - RING_BYTES) / 4; u += NWAVES * 64) ((LAS unsigned*)(L + RING_BYTES))[u] = 0u;
    __syncthreads();
    XcdBarrier bar; bar.bar = ctl + 4096; bar.x = 0; bar.st = nullptr;
    if (!MK_PER_PHASE) bar = xcd_barrier_post(ctl + 4096, MISC + 8);
    const int lo = args.ph_lo, hi_ph = args.ph_hi;
    if (IN(0)) {
        PH_IDS();
        LAS float* scr = (LAS float*)(L + wave * 16384);
#define P0_DESC(it_, kind_, src_, N_, dst_, K_) do { const int l_ = (it_) / 5920; int r_ = (it_) % 5920; kind_ = 0; \
            if (r_ < 4352) { const int kb_ = r_ / 272, nb_ = r_ % 272; N_ = INC; K_ = 1024; src_ = args.in[I_WIN] + (size_t)l_ * 1024 * INC + (size_t)(64 * kb_) * INC + 32 * nb_; \
                if (((WIN_FP8_MASK >> (nb_ >> 3)) & 1ull) == 0ull) { kind_ = 1; dst_ = (void*)(WINT + (size_t)l_ * INC * 1024 + (size_t)(32 * nb_) * 1024 + 64 * kb_); } else { kind_ = 2; dst_ = (void*)(WINT8 + (size_t)l_ * INC * 1024 + (size_t)(32 * nb_) * 1024 + 64 * kb_); } } \
            else if (r_ < 4352 + 1024) { r_ -= 4352; const int i_ = r_ >> 8, q_ = r_ & 255; if (i_ != 0) { kind_ = 1; N_ = 1024; K_ = 512; src_ = args.in[I_WBR] + (size_t)(l_ * 4 + i_) * 512 * 1024 + (size_t)(64 * (q_ / 32)) * 1024 + 32 * (q_ % 32); \
                dst_ = (void*)(WBRT + (size_t)(l_ * 4 + i_) * 1024 * 512 + (size_t)(32 * (q_ % 32)) * 512 + 64 * (q_ / 32)); } } \
            else if (r_ < 4352 + 1024 + 512) { r_ -= 4352 + 1024; kind_ = 1; N_ = 1024; K_ = 1024; src_ = args.in[I_WOUT] + (size_t)l_ * 1024 * 1024 + (size_t)(64 * (r_ / 32)) * 1024 + 32 * (r_ % 32); \
                dst_ = (void*)(WOUTT + (size_t)l_ * 1024 * 1024 + (size_t)(32 * (r_ % 32)) * 1024 + 64 * (r_ / 32)); } } while (0)
#define P0_STORE(kind_, t_, dst_, K_) do { if (kind_ == 1) tr16_store(t_, (bf16_t*)(dst_), K_, scr, lane); else if (kind_ == 2) tr8_store(t_, (unsigned char*)(dst_), K_, 32.f, scr, lane); } while (0)
        {
            f32x4 tA[8], tB[8]; const float* sA = nullptr; const float* sB = nullptr; void* dA = nullptr; void* dB = nullptr; int kA = 0, kB = 0, nA_ = 0, nB_ = 0, KA = 0, KB = 0;
            int it = gw; const int ite = 2 * 5920;
            if (it < ite) { P0_DESC(it, kA, sA, nA_, dA, KA); if (kA) tr8_load(sA, nA_, lane, tA); }
#pragma nounroll
            while (it < ite) {
                if (it + NGW < ite) { P0_DESC(it + NGW, kB, sB, nB_, dB, KB); if (kB) tr8_load(sB, nB_, lane, tB); }
                P0_STORE(kA, tA, dA, KA);
                it += NGW; if (it >= ite) break;
                if (it + NGW < ite) { P0_DESC(it + NGW, kA, sA, nA_, dA, KA); if (kA) tr8_load(sA, nA_, lane, tA); }
                P0_STORE(kB, tB, dB, KB);
                it += NGW;
            }
        }
#undef P0_DESC
#undef P0_STORE
        for (int i = gt; i < 2 * 512 * 256; i += NGT) {
            const int l = i / (512 * 256), r = i % (512 * 256), k = r >> 8, n4 = (r & 255) * 4, g = k >> 7, c = k & 127;
            const float* wp = args.in[I_POOLW] + ((size_t)(l * 4 + g) * 128 + c) * 128; const float* sc = args.in[I_POOLS] + l * 512 + g * 128;
            const float* wb = args.in[I_WBR] + ((size_t)(l * 4) * 512 + g * 128) * 1024 + n4;
            f32x4 acc = {0.f, 0.f, 0.f, 0.f};
#pragma unroll 8
            for (int e = 0; e < 128; ++e) acc += (wp[e] * sc[e]) * *(const f32x4*)(wb + (size_t)e * 1024);
            bf16_t* dst = WBRT + ((size_t)(l * 4) * 1024 + n4) * 512 + k;
            dst[0] = (bf16_t)(cvtpk(acc.x, 0.f) & 0xffffu); dst[512] = (bf16_t)(cvtpk(acc.y, 0.f) & 0xffffu); dst[1024] = (bf16_t)(cvtpk(acc.z, 0.f) & 0xffffu); dst[1536] = (bf16_t)(cvtpk(acc.w, 0.f) & 0xffffu);
        }
        for (int i = gt; i < 2 * 4096; i += NGT) {
            const int l = i >> 12, idx = i & 4095, sidx = idx >> 6, ln = idx & 63, n = ln & 31, hh = ln >> 5; const float* wp = args.in[I_RW] + (size_t)l * 16384 + (size_t)(16 * sidx + 8 * hh) * 16 + (n & 15);
            float w[8];
#pragma unroll
            for (int j = 0; j < 8; ++j) { const float v = wp[j * 16]; const float vh = bflo(cvtpk(v, 0.f)); w[j] = (n < 16) ? v : v - vh; }
            RWBG[i] = (u32x4){cvtpk(w[0], w[1]), cvtpk(w[2], w[3]), cvtpk(w[4], w[5]), cvtpk(w[6], w[7])};
        }
        for (int i = gt; i < 2 * 4 * 128 * 128 / 2; i += NGT) { const float a = args.in[I_SGUW][2 * i], b = args.in[I_SGUW][2 * i + 1]; ((unsigned*)SGUW)[i] = cvtpk(a, b); }
        for (int i = gt; i < 192 * 16; i += NGT) {
            const int pos = i >> 4, f = i & 15; const double inv = pow(10000.0, -(double)f / 16.0);
            const bool isrow = pos < 128; const double ang = (double)(isrow ? pos : pos - 128) * (double)(float)inv;
            const float cv = (float)cos(ang), sv = (float)sin(ang);
            if (isrow) { ROPE[pos * 16 + f] = cv; ROPE[2048 + pos * 16 + f] = sv; } else { ROPE[4096 + (pos - 128) * 16 + f] = cv; ROPE[5120 + (pos - 128) * 16 + f] = sv; }
        }
        if (gw < 2) { const float* lp = args.in[I_LAMP] + gw * 256; const float a = wave_sum(lp[lane] * lp[64 + lane]), b = wave_sum(lp[128 + lane] * lp[192 + lane]);
            const float lam_init = 0.8f - 0.6f * expf(-0.3f * (float)gw); if (lane == 0) LAM[gw] = expf(a) - expf(b) + lam_init; }
        __syncthreads();
        LAS float* red = (LAS float*)L; LAS float* SC = red + 8 * 3 * 64;
        { float tc[6];
#pragma unroll
          for (int q = 0; q < 6; ++q) { const int i = tid + 512 * q; tc[q] = i < 2048 ? args.in[I_C][i] : args.in[I_CCTX][i - 2048]; }
#pragma unroll
          for (int q = 0; q < 6; ++q) SC[tid + 512 * q] = tc[q] * sigmoidf_(tc[q]); }
        __syncthreads();
        for (int it = vcu; it < 2 * 96; it += G) {
            const int l = it / 96, j = (it % 96) * 64 + lane; const float* wm = args.in[I_WMOD] + (size_t)l * 1024 * 6144 + j + (size_t)(wave * 128) * 6144;
            float a0 = 0.f, a1 = 0.f, a2 = 0.f;
#pragma nounroll
            for (int kb = 0; kb < 128; kb += 32) {
                float w[32];
#pragma unroll
                for (int q = 0; q < 32; ++q) w[q] = wm[(size_t)(kb + q) * 6144];
#pragma unroll
                for (int q = 0; q < 32; ++q) { const int k = wave * 128 + kb + q; a0 += SC[k] * w[q]; a1 += SC[1024 + k] * w[q]; a2 += SC[2048 + k] * w[q]; }
            }
            red[(wave * 3 + 0) * 64 + lane] = a0; red[(wave * 3 + 1) * 64 + lane] = a1; red[(wave * 3 + 2) * 64 + lane] = a2;
            __syncthreads();
            if (wave < 3) { float sm = args.in[I_BMOD][l * 6144 + j];
#pragma unroll
                for (int w2 = 0; w2 < 8; ++w2) sm += red[(w2 * 3 + wave) * 64 + lane];
                MOD[(l * 3 + wave) * 6144 + j] = sm; }
            __syncthreads();
        }
        SEAM(0);
    }

    run_layer<0>(args, L, lds, G, bx, vcu, lo, hi_ph, bar);
    run_layer<1>(args, L, lds, G, bx, vcu, lo, hi_ph, bar);
#undef IN
#undef SEAM
}

#undef ws
#undef ctl
#undef SMALL
#undef MOD
#undef ROPE
#undef LAM
#undef SEL
#undef RWBG
#undef AFFL
#undef AFFC
#undef IDXROW
#undef GATE
#undef WINT
#undef WBRT
#undef WOUTT
#undef POOLT
#undef SGUW
#undef X
#undef HX
#undef HX8
#undef WINT8
#undef DP
#undef SVT
#undef QD
#undef KD
#undef VD
#undef NQ
#undef NK
#undef NV
#undef MACC
#undef MB
#undef PZ
#undef O0
#undef SVTR
#undef SVST
#undef SU
#undef SV
#undef NVT
#undef V8T
#undef BR
#undef GZ
#undef W13T
#undef W2T
#undef XS
#undef HID
#undef Y
extern "C" void kernel_launch(void* const* d_in, const int* in_sizes, int n_in, void* d_out, int out_size, void* d_ws, size_t ws_size, hipStream_t stream) {
    static int grid = 0;
    if (grid == 0) {
        if (n_in != 24 || out_size != MLAT * D || ws_size < WS_END) { fprintf(stderr, "kernel_launch: unexpected shapes: n_in %d out %d ws %zu (need %zu)\n", n_in, out_size, ws_size, (size_t)WS_END); grid = -1; return; }
        int dev = 0, cus = 0;
        if (hipGetDevice(&dev) != hipSuccess || hipDeviceGetAttribute(&cus, hipDeviceAttributeMultiprocessorCount, dev) != hipSuccess) { grid = -1; return; }
        if (hipFuncSetAttribute((const void*)mega_fwd, hipFuncAttributeMaxDynamicSharedMemorySize, LDS_BYTES) != hipSuccess) { fprintf(stderr, "kernel_launch: hipFuncSetAttribute failed\n"); grid = -1; return; }
        grid = cus;
    }
    if (grid < 0) return;
    (void)hipMemsetAsync((char*)d_ws + WS_CTL, 0, CTL_ZERO_BYTES, stream);
    Args a{};
    for (int i = 0; i < 24; ++i) a.in[i] = (const float*)d_in[i];
    a.out = (float*)d_out; a.ws = (unsigned char*)d_ws;
#if MK_PER_PHASE
#ifndef PROBE_DUP
#define PROBE_DUP 0u
#endif
    for (int p = 0; p < 25; ++p) { if (p == 13) continue; a.ph_lo = p; a.ph_hi = p + 1;
        for (int rep = 0; rep < (((PROBE_DUP >> p) & 1u) ? 2 : 1); ++rep) hipLaunchKernelGGL(mega_fwd, dim3(grid), dim3(NWAVES * 64), LDS_BYTES, stream, a); }
#else
    a.ph_lo = 0; a.ph_hi = 25;
    hipLaunchKernelGGL(mega_fwd, dim3(grid), dim3(NWAVES * 64), LDS_BYTES, stream, a);
#endif
    const hipError_t le = hipPeekAtLastError();
    if (le != hipSuccess) fprintf(stderr, "kernel_launch: launch failed: %s\n", hipGetErrorName(le));
}
```
